# Optimizing an MI355X kernel written in HIP

```python
import jax, jax.numpy as jnp
from jax import lax
import numpy as np

D_MODEL = 1024
BATCH = 8
SEQ = 2048
DEPTH = 2

D_CONV = D_MODEL // 2
D_POOL = D_MODEL // 2
D_SC = D_MODEL // 2
CONV_A_K = 31
SC_K = 3
POOL_WINDOWS = (2, 4, 8, 16)
N_POOL_GROUPS = len(POOL_WINDOWS)
POOL_GROUP_DIM = D_POOL // N_POOL_GROUPS
POOL_OUT_DIM = D_MODEL // N_POOL_GROUPS
MAX_WINDOW = max(POOL_WINDOWS)
N_BRANCH = 3
PROJ_SPLITS = (D_CONV, 2 * D_CONV, 2 * D_CONV + D_POOL, 2 * D_CONV + D_POOL + D_SC,
               2 * D_CONV + D_POOL + 2 * D_SC, 2 * D_CONV + D_POOL + 3 * D_SC)
D_IN_PROJ = 2 * D_CONV + D_POOL + 3 * D_SC + N_BRANCH * D_MODEL
N_MEM = 256
XATTN_HEADS = 4
XATTN_HEAD_DIM = D_MODEL // XATTN_HEADS
MOE_GROUPS = 4
EXPERTS_PER_GROUP = 4
N_EXPERTS = MOE_GROUPS * EXPERTS_PER_GROUP
EXPERT_TOP_K = 2
D_EXPERT = D_MODEL // 4
EPS = 1e-6

kernel_name = "hybrid_gated_conv_pool_shortconv_hiermoe"


def rmsnorm(x, g):
    xf = x.astype(jnp.float32)
    y = xf * lax.rsqrt(jnp.mean(xf * xf, axis=-1, keepdims=True) + EPS)
    return (y * g.astype(jnp.float32)).astype(x.dtype)


def layernorm(x, g, b):
    xf = x.astype(jnp.float32)
    mu = jnp.mean(xf, axis=-1, keepdims=True)
    var = jnp.mean(jnp.square(xf - mu), axis=-1, keepdims=True)
    y = (xf - mu) * lax.rsqrt(var + EPS)
    return (y * g.astype(jnp.float32) + b.astype(jnp.float32)).astype(x.dtype)


def causal_dwconv(u, w):
    k = w.shape[0]
    u_pad = jnp.pad(u, ((0, 0), (k - 1, 0), (0, 0)))
    return lax.conv_general_dilated(
        u_pad, w[:, None, :].astype(u.dtype), window_strides=(1,), padding='VALID',
        dimension_numbers=('NWC', 'WIO', 'NWC'), feature_group_count=u.shape[-1])


def multiscale_pool_minus_token(u):
    s = u.shape[1]
    uf = u.astype(jnp.float32)
    cs = jnp.cumsum(uf, axis=1)
    cs_pad = jnp.pad(cs, ((0, 0), (MAX_WINDOW, 0), (0, 0)))
    t = jnp.arange(s, dtype=jnp.int32)
    outs = []
    for i, w in enumerate(POOL_WINDOWS):
        c0, c1 = i * POOL_GROUP_DIM, (i + 1) * POOL_GROUP_DIM
        prev = cs_pad[:, MAX_WINDOW - w:MAX_WINDOW - w + s, c0:c1]
        cnt = jnp.minimum(t + 1, w).astype(jnp.float32)[None, :, None]
        outs.append((cs[:, :, c0:c1] - prev) / cnt - uf[:, :, c0:c1])
    return jnp.concatenate(outs, axis=-1).astype(u.dtype)


def gated_branch_mixer(h, w_in, conv_a_w, conv_a_b, ln_a_g, ln_a_b, w_a_out,
                       w_pool_grp, pool_scale, conv_c_w, w_c_out, w_o):
    bsz, s, _ = h.shape
    proj = h @ w_in
    a_val, a_gate, u_pool, c_x, c_b, c_c, g = jnp.split(proj, PROJ_SPLITS, axis=-1)
    a = a_val * jax.nn.sigmoid(a_gate)
    a = causal_dwconv(a, conv_a_w) + conv_a_b
    a = jax.nn.silu(layernorm(a, ln_a_g, ln_a_b)) @ w_a_out
    p = multiscale_pool_minus_token(u_pool).reshape(bsz, s, N_POOL_GROUPS, POOL_GROUP_DIM)
    p = jnp.einsum('bsgc,gco->bsgo', p, w_pool_grp).reshape(bsz, s, D_MODEL) * pool_scale
    c = (c_b * causal_dwconv(c_c * c_x, conv_c_w)) @ w_c_out
    gates = jax.nn.sigmoid(g).reshape(bsz, s, N_BRANCH, D_MODEL)
    merged = gates[:, :, 0] * a + gates[:, :, 1] * p + gates[:, :, 2] * c
    return merged @ w_o


def memory_cross_attention(h, mem_n, w_xq, w_xkv, w_xo):
    bsz, s, _ = h.shape
    q = (h @ w_xq).reshape(bsz, s, XATTN_HEADS, XATTN_HEAD_DIM)
    k, v = jnp.split(mem_n @ w_xkv, 2, axis=-1)
    k = k.reshape(bsz, N_MEM, XATTN_HEADS, XATTN_HEAD_DIM)
    v = v.reshape(bsz, N_MEM, XATTN_HEADS, XATTN_HEAD_DIM)
    scores = jnp.einsum('bshd,bmhd->bhsm', q, k).astype(jnp.float32) * (XATTN_HEAD_DIM ** -0.5)
    probs = jax.nn.softmax(scores, axis=-1).astype(v.dtype)
    o = jnp.einsum('bhsm,bmhd->bshd', probs, v).reshape(bsz, s, D_MODEL)
    return o @ w_xo


def hierarchical_moe(h, w_rg, b_rg, w_re, b_re, w_e_gate, w_e_up, w_e_down):
    bsz, s, d = h.shape
    t = h.reshape(-1, d)
    n = t.shape[0]
    p_grp = jax.nn.softmax((t @ w_rg + b_rg).astype(jnp.float32), axis=-1)
    g_val, g_idx = lax.top_k(p_grp, 1)
    le = (t @ w_re + b_re).astype(jnp.float32).reshape(n, MOE_GROUPS, EXPERTS_PER_GROUP)
    le_sel = jnp.take_along_axis(le, g_idx[:, :, None], axis=1)[:, 0]
    p_exp = jax.nn.softmax(le_sel, axis=-1)
    e_val, e_idx = lax.top_k(p_exp, EXPERT_TOP_K)
    e_val = e_val / jnp.sum(e_val, axis=-1, keepdims=True)
    weight = g_val * e_val
    eid = g_idx * EXPERTS_PER_GROUP + e_idx
    gate = jnp.sum(jax.nn.one_hot(eid, N_EXPERTS, dtype=jnp.float32) * weight[..., None], axis=1)
    act = jax.nn.silu(jnp.einsum('nd,edf->nef', t, w_e_gate)) * jnp.einsum('nd,edf->nef', t, w_e_up)
    act = act * gate[:, :, None].astype(act.dtype)
    out = jnp.einsum('nef,efd->nd', act, w_e_down)
    return out.reshape(bsz, s, d)


def setup_inputs(seed: int = 0) -> dict:
    key = jax.random.key(seed)
    ks = jax.random.split(key, 32)
    f32 = jnp.float32

    def nrm(k, shape, scale):
        return jax.random.normal(k, shape, f32) * scale

    def gain(k, shape):
        return 1.0 + 0.02 * jax.random.normal(k, shape, f32)

    L = DEPTH
    return {
        "x": nrm(ks[0], (BATCH, SEQ, D_MODEL), 1.0),
        "mem": nrm(ks[1], (BATCH, N_MEM, D_MODEL), 1.0),
        "norm_mix_g": gain(ks[2], (L, D_MODEL)),
        "w_in": nrm(ks[3], (L, D_MODEL, D_IN_PROJ), D_MODEL ** -0.5),
        "conv_a_w": nrm(ks[4], (L, CONV_A_K, D_CONV), CONV_A_K ** -0.5),
        "conv_a_b": nrm(ks[5], (L, D_CONV), 0.02),
        "ln_a_g": gain(ks[6], (L, D_CONV)),
        "ln_a_b": nrm(ks[7], (L, D_CONV), 0.02),
        "w_a_out": nrm(ks[8], (L, D_CONV, D_MODEL), D_CONV ** -0.5),
        "w_pool_grp": nrm(ks[9], (L, N_POOL_GROUPS, POOL_GROUP_DIM, POOL_OUT_DIM), POOL_GROUP_DIM ** -0.5),
        "pool_scale": gain(ks[10], (L, D_MODEL)),
        "conv_c_w": nrm(ks[11], (L, SC_K, D_SC), SC_K ** -0.5),
        "w_c_out": nrm(ks[12], (L, D_SC, D_MODEL), D_SC ** -0.5),
        "w_o": nrm(ks[13], (L, D_MODEL, D_MODEL), D_MODEL ** -0.5),
        "norm_x_g": gain(ks[14], (L, D_MODEL)),
        "norm_mem_g": gain(ks[15], (L, D_MODEL)),
        "w_xq": nrm(ks[16], (L, D_MODEL, D_MODEL), D_MODEL ** -0.5),
        "w_xkv": nrm(ks[17], (L, D_MODEL, 2 * D_MODEL), D_MODEL ** -0.5),
        "w_xo": nrm(ks[18], (L, D_MODEL, D_MODEL), D_MODEL ** -0.5),
        "norm_ffn_g": gain(ks[19], (L, D_MODEL)),
        "w_rg": nrm(ks[20], (L, D_MODEL, MOE_GROUPS), D_MODEL ** -0.5),
        "b_rg": nrm(ks[21], (L, MOE_GROUPS), 0.01),
        "w_re": nrm(ks[22], (L, D_MODEL, N_EXPERTS), D_MODEL ** -0.5),
        "b_re": nrm(ks[23], (L, N_EXPERTS), 0.01),
        "w_e_gate": nrm(ks[24], (L, N_EXPERTS, D_MODEL, D_EXPERT), D_MODEL ** -0.5),
        "w_e_up": nrm(ks[25], (L, N_EXPERTS, D_MODEL, D_EXPERT), D_MODEL ** -0.5),
        "w_e_down": nrm(ks[26], (L, N_EXPERTS, D_EXPERT, D_MODEL), D_EXPERT ** -0.5),
        "norm_f_g": gain(ks[27], (D_MODEL,)),
    }


def reference(x, mem, norm_mix_g, w_in, conv_a_w, conv_a_b, ln_a_g, ln_a_b, w_a_out,
              w_pool_grp, pool_scale, conv_c_w, w_c_out, w_o, norm_x_g, norm_mem_g,
              w_xq, w_xkv, w_xo, norm_ffn_g, w_rg, b_rg, w_re, b_re,
              w_e_gate, w_e_up, w_e_down, norm_f_g):
    for l in range(DEPTH):
        h = rmsnorm(x, norm_mix_g[l])
        x = x + gated_branch_mixer(h, w_in[l], conv_a_w[l], conv_a_b[l], ln_a_g[l], ln_a_b[l],
                                   w_a_out[l], w_pool_grp[l], pool_scale[l], conv_c_w[l],
                                   w_c_out[l], w_o[l])
        x = x + memory_cross_attention(rmsnorm(x, norm_x_g[l]), rmsnorm(mem, norm_mem_g[l]),
                                       w_xq[l], w_xkv[l], w_xo[l])
        x = x + hierarchical_moe(rmsnorm(x, norm_ffn_g[l]), w_rg[l], b_rg[l], w_re[l], b_re[l],
                                 w_e_gate[l], w_e_up[l], w_e_down[l])
    return rmsnorm(x, norm_f_g)
```

```cpp
#include <hip/hip_runtime.h>
#include <cstdio>
#include <cstdint>

namespace {
constexpr int DM = 1024, SEQ = 2048, NBATCH = 8, NTOK = NBATCH * SEQ, DEPTH = 2;
constexpr int DC = 512, NPROJ = 6144, NMEM = 256, NH = 4, HD = 256, NE = 16, DE = 256;
constexpr float EPS = 1e-6f;

__device__ __forceinline__ float sigmoidf_(float v) { return 1.f / (1.f + __expf(-v)); }

__device__ __forceinline__ float block_sum(float v, float* red) {
    for (int o = 32; o > 0; o >>= 1) v += __shfl_xor(v, o);
    const int w = threadIdx.x >> 6, nw = blockDim.x >> 6;
    __syncthreads();
    if ((threadIdx.x & 63) == 0) red[w] = v;
    __syncthreads();
    float s = 0.f;
    for (int i = 0; i < nw; ++i) s += red[i];
    return s;
}

__global__ __launch_bounds__(256) void k_rmsnorm(const float* x, const float* g, float* out) {
    __shared__ float red[8];
    const size_t r = blockIdx.x;
    const float4 v = ((const float4*)(x + r * DM))[threadIdx.x];
    float s = v.x * v.x + v.y * v.y + v.z * v.z + v.w * v.w;
    s = block_sum(s, red);
    const float rstd = rsqrtf(s * (1.f / DM) + EPS);
    const float4 gg = ((const float4*)g)[threadIdx.x];
    float4 o; o.x = v.x * rstd * gg.x; o.y = v.y * rstd * gg.y; o.z = v.z * rstd * gg.z; o.w = v.w * rstd * gg.w;
    ((float4*)(out + r * DM))[threadIdx.x] = o;
}

struct GemmP { const float* A; const float* B; float* C; long sbk, sbn, bsA, bsB, bsC; int M, N, K, lda, ldc, accumulate; };
__global__ __launch_bounds__(256) void k_sgemm(GemmP p) {
    __shared__ float As[16][68];
    __shared__ float Bs[16][68];
    const int tx = threadIdx.x & 15, ty = threadIdx.x >> 4;
    const float* A = p.A + (long)blockIdx.z * p.bsA + (long)blockIdx.y * 64 * p.lda;
    const float* B = p.B + (long)blockIdx.z * p.bsB + (long)blockIdx.x * 64 * p.sbn;
    float* C = p.C + (long)blockIdx.z * p.bsC;
    float acc[4][4];
    for (int i = 0; i < 4; ++i) for (int j = 0; j < 4; ++j) acc[i][j] = 0.f;
    const int am = threadIdx.x >> 2, akq = (threadIdx.x & 3) * 4;
    for (int k0 = 0; k0 < p.K; k0 += 16) {
        const float4 av = *(const float4*)(A + (long)am * p.lda + k0 + akq);
        As[akq + 0][am] = av.x; As[akq + 1][am] = av.y; As[akq + 2][am] = av.z; As[akq + 3][am] = av.w;
        for (int i = 0; i < 4; ++i) {
            const int idx = threadIdx.x + i * 256, k = idx >> 6, n = idx & 63;
            Bs[k][n] = B[(long)(k0 + k) * p.sbk + (long)n * p.sbn];
        }
        __syncthreads();
#pragma unroll
        for (int kk = 0; kk < 16; ++kk) {
            float a[4], b[4];
            for (int i = 0; i < 4; ++i) a[i] = As[kk][ty * 4 + i];
            for (int j = 0; j < 4; ++j) b[j] = Bs[kk][tx * 4 + j];
            for (int i = 0; i < 4; ++i) for (int j = 0; j < 4; ++j) acc[i][j] += a[i] * b[j];
        }
        __syncthreads();
    }
    for (int i = 0; i < 4; ++i) for (int j = 0; j < 4; ++j) {
        float* c = C + (long)(blockIdx.y * 64 + ty * 4 + i) * p.ldc + blockIdx.x * 64 + tx * 4 + j;
        *c = p.accumulate ? (*c + acc[i][j]) : acc[i][j];
    }
}

__global__ __launch_bounds__(512) void k_glu(const float* proj, float* a) {
    const size_t t = blockIdx.x; const int c = threadIdx.x;
    a[t * DC + c] = proj[t * NPROJ + c] * sigmoidf_(proj[t * NPROJ + 512 + c]);
}
__global__ __launch_bounds__(512) void k_branchA(const float* a, const float* cw, const float* cb, const float* lg, const float* lb, float* out) {
    __shared__ float red[8];
    const int t = blockIdx.x, c = threadIdx.x;
    float v = cb[c];
    for (int k = 0; k < 31; ++k) { const int tt = t - 30 + k; if (tt >= 0) v += cw[k * DC + c] * a[(size_t)tt * DC + c]; }
    const float mu = block_sum(v, red) * (1.f / DC);
    const float d = v - mu;
    const float var = block_sum(d * d, red) * (1.f / DC);
    const float y = d * rsqrtf(var + EPS) * lg[c] + lb[c];
    out[(size_t)t * DC + c] = y * sigmoidf_(y);
}
__global__ __launch_bounds__(512) void k_pool(const float* proj, float* out) {
    const int t = blockIdx.x, c = threadIdx.x;
    const int w = 2 << (c >> 7);
    float s = 0.f;
    for (int j = 0; j < w; ++j) if (t - j >= 0) s += proj[(size_t)(t - j) * NPROJ + 1024 + c];
    const int cnt = (t + 1 < w) ? (t + 1) : w;
    out[(size_t)t * DC + c] = s / (float)cnt - proj[(size_t)t * NPROJ + 1024 + c];
}
__global__ __launch_bounds__(512) void k_branchC(const float* proj, const float* cw, float* out) {
    const int t = blockIdx.x, c = threadIdx.x;
    float v = 0.f;
    for (int k = 0; k < 3; ++k) { const int tt = t - 2 + k; if (tt >= 0) v += cw[k * DC + c] * proj[(size_t)tt * NPROJ + 2560 + c] * proj[(size_t)tt * NPROJ + 1536 + c]; }
    out[(size_t)t * DC + c] = proj[(size_t)t * NPROJ + 2048 + c] * v;
}
__global__ __launch_bounds__(256) void k_merge(const float* proj, const float* ba, const float* bp, const float* bc, const float* ps, float* merged) {
    const size_t t = blockIdx.x;
    for (int c = threadIdx.x; c < DM; c += 256) {
        const float g0 = sigmoidf_(proj[t * NPROJ + 3072 + c]), g1 = sigmoidf_(proj[t * NPROJ + 4096 + c]), g2 = sigmoidf_(proj[t * NPROJ + 5120 + c]);
        merged[t * DM + c] = g0 * ba[t * DM + c] + g1 * bp[t * DM + c] * ps[c] + g2 * bc[t * DM + c];
    }
}
__global__ __launch_bounds__(256) void k_softmax256(float* s, float sc) {
    const size_t r = (size_t)blockIdx.x * 4 + (threadIdx.x >> 6); const int l = threadIdx.x & 63;
    float4 v = ((float4*)(s + r * 256))[l];
    v.x *= sc; v.y *= sc; v.z *= sc; v.w *= sc;
    float m = fmaxf(fmaxf(v.x, v.y), fmaxf(v.z, v.w));
    for (int o = 32; o > 0; o >>= 1) m = fmaxf(m, __shfl_xor(m, o));
    v.x = __expf(v.x - m); v.y = __expf(v.y - m); v.z = __expf(v.z - m); v.w = __expf(v.w - m);
    float sum = v.x + v.y + v.z + v.w;
    for (int o = 32; o > 0; o >>= 1) sum += __shfl_xor(sum, o);
    const float inv = 1.f / sum;
    v.x *= inv; v.y *= inv; v.z *= inv; v.w *= inv;
    ((float4*)(s + r * 256))[l] = v;
}
__global__ __launch_bounds__(64) void k_router(const float* t, const float* wrg, const float* brg, const float* wre, const float* bre, float* gate) {
    const size_t n = blockIdx.x; const int l = threadIdx.x;
    float acc[20];
    for (int j = 0; j < 20; ++j) acc[j] = 0.f;
    for (int k = l; k < DM; k += 64) {
        const float tv = t[n * DM + k];
        for (int j = 0; j < 4; ++j) acc[j] += tv * wrg[k * 4 + j];
        for (int j = 0; j < 16; ++j) acc[4 + j] += tv * wre[k * 16 + j];
    }
    for (int j = 0; j < 20; ++j) for (int o = 32; o > 0; o >>= 1) acc[j] += __shfl_xor(acc[j], o);
    if (l == 0) {
        float lg[4]; int gi = 0;
        for (int j = 0; j < 4; ++j) { lg[j] = acc[j] + brg[j]; if (lg[j] > lg[gi]) gi = j; }
        float se = 0.f; for (int j = 0; j < 4; ++j) se += __expf(lg[j] - lg[gi]);
        const float gval = 1.f / se;
        float le[4]; for (int j = 0; j < 4; ++j) le[j] = acc[4 + gi * 4 + j] + bre[gi * 4 + j];
        int e1 = 0; for (int j = 1; j < 4; ++j) if (le[j] > le[e1]) e1 = j;
        int e2 = -1; for (int j = 0; j < 4; ++j) if (j != e1 && (e2 < 0 || le[j] > le[e2])) e2 = j;
        const float p2 = __expf(le[e2] - le[e1]);
        const float w1 = gval / (1.f + p2), w2 = gval * p2 / (1.f + p2);
        for (int j = 0; j < 16; ++j) gate[n * 16 + j] = 0.f;
        gate[n * 16 + gi * 4 + e1] = w1; gate[n * 16 + gi * 4 + e2] = w2;
    }
}
__global__ __launch_bounds__(256) void k_moe_act(float* G, const float* U, const float* gate, int gi) {
    const size_t n = blockIdx.x;
    for (int c = threadIdx.x; c < 1024; c += 256) {
        const float g = G[n * 1024 + c], u = U[n * 1024 + c];
        G[n * 1024 + c] = g * sigmoidf_(g) * u * gate[n * 16 + gi * 4 + (c >> 8)];
    }
}

void gemm(hipStream_t st, const float* A, const float* B, float* C, int M, int N, int K, int lda, long sbk, long sbn, int ldc, int acc,
          int batch = 1, long bsA = 0, long bsB = 0, long bsC = 0) {
    GemmP p{}; p.A = A; p.B = B; p.C = C; p.M = M; p.N = N; p.K = K; p.lda = lda; p.sbk = sbk; p.sbn = sbn; p.ldc = ldc; p.bsA = bsA; p.bsB = bsB; p.bsC = bsC; p.accumulate = acc;
    hipLaunchKernelGGL(k_sgemm, dim3(N / 64, M / 64, batch), dim3(256), 0, st, p);
}
}


namespace mk {
#define LAS __attribute__((address_space(3)))
typedef unsigned short bf16_t;
typedef short bf16x8 __attribute__((ext_vector_type(8)));
typedef float f32x4 __attribute__((ext_vector_type(4)));
typedef float f32x2 __attribute__((ext_vector_type(2)));
typedef float f32x16 __attribute__((ext_vector_type(16)));
typedef unsigned u32x4 __attribute__((ext_vector_type(4)));
typedef unsigned u32x2 __attribute__((ext_vector_type(2)));
typedef __bf16 bf16x2_t __attribute__((ext_vector_type(2)));

constexpr int NTHREADS = 512, NWAVES = 8;
constexpr int RING_BYTES = 131072, CTRL_OFF = 135168  , MISC_OFF = CTRL_OFF + 320, LDS_BYTES = CTRL_OFF + 12288;
constexpr int NTOK = 16384, DM = 1024, SEQ = 2048;
constexpr float EPS = 1e-6f;

__device__ __forceinline__ unsigned pk2(float lo, float hi) { f32x2 v = {lo, hi}; bf16x2_t b = __builtin_convertvector(v, bf16x2_t); return __builtin_bit_cast(unsigned, b); }
__device__ __forceinline__ float bf_lo(unsigned w) { return __uint_as_float(w << 16); }
__device__ __forceinline__ float bf_hi(unsigned w) { return __uint_as_float(w & 0xffff0000u); }
__device__ __forceinline__ float sigm(float v) { return __builtin_amdgcn_rcpf(1.f + __builtin_amdgcn_exp2f(-1.4426950408889634f * v)); }

#define XB_TMO      128
#define XB_XCNT(j)  (256  + 64 * (j))
#define XB_XSUB(j)  (1280 + 64 * (j))
#define XB_XGEN(j)  (2304 + 64 * (j))
#define XB_TOP      3328
#define XB_TOPGEN   3392
#define XCD_BAR_WORDS 3456
#define XB_SPIN_CAP (1u << 18)
__device__ __forceinline__ unsigned xb_ld(unsigned* p)              { return __hip_atomic_load(p, __ATOMIC_RELAXED, __HIP_MEMORY_SCOPE_AGENT); }
__device__ __forceinline__ unsigned xb_add(unsigned* p, unsigned v) { return __hip_atomic_fetch_add(p, v, __ATOMIC_RELAXED, __HIP_MEMORY_SCOPE_AGENT); }
__device__ __forceinline__ unsigned xb_xcc_id() { return (unsigned)__builtin_amdgcn_s_getreg((3 << 11) | 20) & 0xFu; }
#define XB_SPIN(cond, bar) do { unsigned _sp = 0; while (cond) { __builtin_amdgcn_s_sleep(1); \
    if ((++_sp & 255u) == 0u) { if (xb_ld(&(bar)[XB_TMO])) break; if (_sp > XB_SPIN_CAP) { atomicAdd(&(bar)[XB_TMO], 1u); break; } } } } while (0)
struct XcdBarrier { unsigned* bar; unsigned x; volatile LAS unsigned* st; };
__device__ __forceinline__ XcdBarrier xcd_barrier_post(unsigned* bar, volatile LAS unsigned* st) {
    XcdBarrier b; b.bar = bar; b.x = xb_xcc_id(); b.st = st;
    if (threadIdx.x == 0) (void)xb_add(&bar[XB_XCNT(b.x)], 1u);
    return b;
}
__device__ __forceinline__ void xcd_barrier_complete(unsigned* bar, unsigned x, unsigned& nloc, unsigned& nx) {
    const unsigned G = gridDim.x * gridDim.y * gridDim.z;
    unsigned sum, cnt, mine, sp = 0u;
    for (;;) {
        sum = 0u; cnt = 0u; mine = 0u;
#pragma unroll
        for (unsigned j = 0; j < 16; ++j) { const unsigned c = xb_ld(&bar[XB_XCNT(j)]); sum += c; cnt += (c > 0u) ? 1u : 0u; mine = (j == x) ? c : mine; }
        if (sum == G) break;
        __builtin_amdgcn_s_sleep(1);
        if ((++sp & 255u) == 0u) { if (xb_ld(&bar[XB_TMO])) break; if (sp > XB_SPIN_CAP) { atomicAdd(&bar[XB_TMO], 1u); break; } }
    }
    nloc = mine > 0u ? mine : 1u; nx = cnt > 0u ? cnt : 1u;
}
__device__ __forceinline__ void xcd_barrier(const XcdBarrier& b) {
    asm volatile("s_waitcnt vmcnt(0)" ::: "memory");
    __syncthreads();
    if (threadIdx.x == 0) {
        unsigned* bar = b.bar;
        __builtin_amdgcn_s_waitcnt(0);
        unsigned nloc = b.st[0], nx = b.st[1];
        if (nloc == 0u) { xcd_barrier_complete(bar, b.x, nloc, nx); b.st[0] = nloc; b.st[1] = nx; }
        const unsigned old = xb_add(&bar[XB_XSUB(b.x)], 1u);
        const unsigned gen = old / nloc;
        if (old + 1u == (gen + 1u) * nloc) {
            __builtin_amdgcn_fence(__ATOMIC_RELEASE, "agent");
            asm volatile("s_waitcnt vmcnt(0)" ::: "memory");
            const unsigned og = xb_add(&bar[XB_TOP], 1u);
            const unsigned tg = og / nx;
            if (og + 1u == (tg + 1u) * nx) xb_add(&bar[XB_TOPGEN], 1u);
            else XB_SPIN(xb_ld(&bar[XB_TOPGEN]) == tg, bar);
            __builtin_amdgcn_fence(__ATOMIC_ACQUIRE, "agent");
            xb_add(&bar[XB_XGEN(b.x)], 1u);
            asm volatile("s_waitcnt vmcnt(0)" ::: "memory");
        } else {
            XB_SPIN(xb_ld(&bar[XB_XGEN(b.x)]) == gen, bar);
            __builtin_amdgcn_fence(__ATOMIC_ACQUIRE, "agent");
            asm volatile("s_waitcnt vmcnt(0)" ::: "memory");
        }
    }
    __syncthreads();
}

namespace g8 {
constexpr int BM = 256, BK = 64, HALF = 128, HTB = HALF * BK * 2, STAGE_BYTES = 8 * HTB, NXCD = 8, WGM = 8;
__device__ __forceinline__ int lds_byte(int r, int c) { const int st = (r >> 4) * 2 + (c >> 5), rr = r & 15, cc = c & 31, ob = rr * 64 + cc * 2; return st * 1024 + (ob ^ (((ob >> 9) & 1) << 5)); }
__device__ __forceinline__ void stage_rc(int b, int& R, int& C) { const int st = b / 1024, sb = b % 1024, swz = sb ^ (((sb >> 9) & 1) << 5); R = (st >> 1) * 16 + swz / 64; C = (st & 1) * 32 + (swz % 64) / 2; }

struct Unit { unsigned A, B; const int* gth; int nt, pm, pn, kind, nvalid; };

__device__ __forceinline__ bool static_tile(int nM, int nN, int G, int c, int i, int& pm, int& pn) {
    const int nwg = nM * nN; const long L = (long)i * G + c; if (L >= nwg) return false;
    int wgid = (int)L; { const int q = nwg / NXCD, r = nwg % NXCD, xcd = wgid % NXCD, off = wgid / NXCD; wgid = (xcd < r ? xcd * (q + 1) : r * (q + 1) + (xcd - r) * q) + off; }
    const int nig = WGM * nN, gid = wgid / nig, fm = gid * WGM, gsz = (nM - fm) < WGM ? (nM - fm) : WGM;
    pm = fm + ((wgid % nig) % gsz); pn = (wgid % nig) / gsz; return true;
}

template <bool GATHER, class Epi, class Sched>
__device__ __forceinline__ void gemm_phase_t(LAS unsigned char* lds, const Sched& S, const Epi& E) {
    int tid_ = threadIdx.x; asm volatile("" : "+v"(tid_));
    const int tid = tid_, wid = __builtin_amdgcn_readfirstlane(tid >> 6), lane = tid & 63, wr = wid >> 2, wc = wid & 3, fr = lane & 15, fq = lane >> 4;
    const unsigned lda = S.lda, ldb = S.ldb;
    unsigned voffA[2], voffB[2], voffA1[2];
#pragma unroll
    for (int i = 0; i < 2; ++i) { int R, C; stage_rc(tid * 16 + i * 8192, R, C); voffA[i] = (unsigned)R * lda + (unsigned)C * 2u; voffB[i] = (unsigned)R * ldb + (unsigned)C * 2u; voffA1[i] = voffA[i]; }
    constexpr int GOFF_OFF = CTRL_OFF + 4096;
#define G8_GOFF(u, o0, o1) do { _Pragma("unroll") for (int _i = 0; _i < 2; ++_i) { int R_, C_; stage_rc(tid * 16 + _i * 8192, R_, C_); const int r0_ = R_, r1_ = 128 + R_; \
        const int t0_ = (r0_ < (u).nvalid) ? (u).gth[r0_] : 0, t1_ = (r1_ < (u).nvalid) ? (u).gth[r1_] : 0; \
        o0[_i] = (unsigned)t0_ * lda + (unsigned)C_ * 2u; o1[_i] = (unsigned)t1_ * lda + (unsigned)C_ * 2u; asm volatile("" : "+v"(o0[_i]), "+v"(o1[_i])); } } while (0)
    const unsigned kstep = (unsigned)(BK * 2);
    const unsigned hsA = GATHER ? 0u : (unsigned)HALF * lda, hsB = (unsigned)HALF * ldb;
    const __amdgpu_buffer_rsrc_t rsrc = __builtin_amdgcn_make_buffer_rsrc((void*)S.ws, 0, 0x7ffffff0, 0x00020000);
    const unsigned ldsw = (unsigned)wid * 1024u;
    const int aoff = lds_byte(wr * 64 + fr, fq * 8), boff = lds_byte(wc * 32 + fr, fq * 8);
#define G8_SA(b, h) (((b) * 2 + (h)) * HTB)
#define G8_SB(b, h) ((4 + (b) * 2 + (h)) * HTB)
#define G8_STAGE(bufoff, gbase, voff) do { _Pragma("unroll") for (int _i = 0; _i < 2; ++_i) \
        __builtin_amdgcn_raw_ptr_buffer_load_lds(rsrc, (LAS void*)(lds + (bufoff) + ldsw + _i * 8192), 16, (int)(voff)[_i], (int)(gbase), 0, 0); } while (0)
#define G8_LDA(dst, b, h) do { _Pragma("unroll") for (int m = 0; m < 4; ++m) _Pragma("unroll") for (int k = 0; k < 2; ++k) dst[m][k] = *(const LAS bf16x8*)(lds + G8_SA(b, h) + aoff + m * 2048 + k * 1024); } while (0)
#define G8_LDB(dst, b, h) do { _Pragma("unroll") for (int n = 0; n < 2; ++n) _Pragma("unroll") for (int k = 0; k < 2; ++k) dst[n][k] = *(const LAS bf16x8*)(lds + G8_SB(b, h) + boff + n * 2048 + k * 1024); } while (0)
#define G8_MMA(ai, bj, At, Bt) do { __builtin_amdgcn_s_setprio(1); _Pragma("unroll") for (int m = 0; m < 4; ++m) _Pragma("unroll") for (int n = 0; n < 2; ++n) _Pragma("unroll") for (int k = 0; k < 2; ++k) \
        acc[ai][bj][m][n] = __builtin_amdgcn_mfma_f32_16x16x32_bf16(Bt[n][k], At[m][k], acc[ai][bj][m][n], 0, 0, 0); __builtin_amdgcn_s_setprio(0); } while (0)
#define G8_WAIT_V(n) asm volatile("s_waitcnt vmcnt(" #n ")" ::: "memory")
#define G8_WAIT_L(n) asm volatile("s_waitcnt lgkmcnt(" #n ")" ::: "memory")
#define G8_BAR __builtin_amdgcn_s_barrier()
#define G8_SCHED __builtin_amdgcn_sched_barrier(0)
    Unit cur, nxt; int ui = 0;
    if (!S.next(0, cur)) return;
    f32x4 acc[2][2][4][2];
#pragma unroll
    for (int a = 0; a < 2; ++a)
#pragma unroll
        for (int b = 0; b < 2; ++b)
#pragma unroll
            for (int m = 0; m < 4; ++m)
#pragma unroll
                for (int n = 0; n < 2; ++n) acc[a][b][m][n] = (f32x4){0.f, 0.f, 0.f, 0.f};
    bf16x8 At[4][2], B0[2][2], B1[2][2];
    unsigned cA = cur.A, cB = cur.B;
    if constexpr (GATHER) G8_GOFF(cur, voffA, voffA1);
    G8_STAGE(G8_SB(0, 0), cB, voffB); G8_STAGE(G8_SB(0, 1), cB + hsB, voffB); G8_STAGE(G8_SA(0, 0), cA, voffA); G8_STAGE(G8_SA(0, 1), cA + hsA, voffA1);
    if (wr == 1) G8_BAR;
    G8_WAIT_V(2); G8_BAR;
    G8_STAGE(G8_SB(1, 0), cB + kstep, voffB); G8_STAGE(G8_SA(1, 0), cA + kstep, voffA); G8_STAGE(G8_SB(1, 1), cB + hsB + kstep, voffB);
    G8_WAIT_V(6); G8_BAR;
    for (;;) {
        const bool has_next = S.next(ui + 1, nxt);
        const unsigned nA = has_next ? nxt.A : cA, nB = has_next ? nxt.B : cB;
        if constexpr (GATHER) { unsigned go0[2], go1[2]; if (has_next) G8_GOFF(nxt, go0, go1); else { go0[0] = voffA[0]; go0[1] = voffA[1]; go1[0] = voffA1[0]; go1[1] = voffA1[1]; }
            *(LAS u32x4*)(lds + GOFF_OFF + tid * 16) = (u32x4){go0[0], go0[1], go1[0], go1[1]}; }
        const int nt = cur.nt;
#pragma unroll 1
        for (int t = 0; t < nt; t += 2) {
            const bool last = (t == nt - 2);
            const unsigned a1 = cA + (unsigned)(t + 1) * kstep;
            const unsigned a2 = last ? nA : cA + (unsigned)(t + 2) * kstep, b2 = last ? nB : cB + (unsigned)(t + 2) * kstep;
            const unsigned a3 = a2 + kstep, b3 = b2 + kstep;
            unsigned o2h0[2], o2h1[2];
            if constexpr (GATHER) { o2h0[0] = voffA[0]; o2h0[1] = voffA[1]; o2h1[0] = voffA1[0]; o2h1[1] = voffA1[1];
                if (last) { const u32x4 nv_ = *(const LAS u32x4*)(lds + GOFF_OFF + tid * 16); o2h0[0] = nv_.x; o2h0[1] = nv_.y; o2h1[0] = nv_.z; o2h1[1] = nv_.w; } }
            else { o2h0[0] = voffA[0]; o2h0[1] = voffA[1]; o2h1[0] = voffA[0]; o2h1[1] = voffA[1]; }
            G8_LDB(B0, 0, 0); G8_LDB(B1, 0, 1); G8_SCHED; G8_LDA(At, 0, 0); G8_STAGE(G8_SA(1, 1), a1 + hsA, voffA1);
            G8_WAIT_V(8); G8_WAIT_L(0); G8_BAR; G8_MMA(0, 0, At, B0); G8_MMA(0, 1, At, B1); G8_BAR; G8_SCHED;
            G8_LDA(At, 0, 1); G8_STAGE(G8_SB(0, 0), b2, voffB); G8_STAGE(G8_SB(0, 1), b2 + hsB, voffB); G8_STAGE(G8_SA(0, 0), a2, o2h0);
            G8_WAIT_V(8); G8_WAIT_L(0); G8_BAR; G8_MMA(1, 0, At, B0); G8_MMA(1, 1, At, B1); G8_BAR; G8_SCHED;
            G8_LDB(B0, 1, 0); G8_LDB(B1, 1, 1); G8_SCHED; G8_LDA(At, 1, 0); G8_STAGE(G8_SA(0, 1), a2 + hsA, o2h1);
            G8_WAIT_V(8); G8_WAIT_L(0); G8_BAR; G8_MMA(0, 0, At, B0); G8_MMA(0, 1, At, B1); G8_BAR; G8_SCHED;
            G8_LDA(At, 1, 1); G8_STAGE(G8_SB(1, 0), b3, voffB); G8_STAGE(G8_SB(1, 1), b3 + hsB, voffB); G8_STAGE(G8_SA(1, 0), a3, o2h0);
            G8_WAIT_V(8); G8_WAIT_L(0); G8_BAR; G8_MMA(1, 0, At, B0); G8_MMA(1, 1, At, B1); G8_BAR; G8_SCHED;
        }
        if (wr == 0) G8_BAR;
        { int fr_ = fr, fq_ = fq; asm volatile("" : "+v"(fr_), "+v"(fq_)); E(acc, cur, wr, wc, fr_, fq_); }
        if (!has_next) break;
#pragma unroll
        for (int a = 0; a < 2; ++a)
#pragma unroll
            for (int b = 0; b < 2; ++b)
#pragma unroll
                for (int m = 0; m < 4; ++m)
#pragma unroll
                    for (int n = 0; n < 2; ++n) acc[a][b][m][n] = (f32x4){0.f, 0.f, 0.f, 0.f};
        cur = nxt; cA = nA; cB = nB; ++ui;
        if constexpr (GATHER) { const u32x4 nv_ = *(const LAS u32x4*)(lds + GOFF_OFF + tid * 16); voffA[0] = nv_.x; voffA[1] = nv_.y; voffA1[0] = nv_.z; voffA1[1] = nv_.w; }
        if (wr == 1) G8_BAR;
    }
    G8_WAIT_V(0);
    G8_BAR;
#undef G8_GOFF
#undef G8_SA
#undef G8_SB
#undef G8_STAGE
#undef G8_LDA
#undef G8_LDB
#undef G8_MMA
#undef G8_WAIT_V
#undef G8_WAIT_L
#undef G8_BAR
#undef G8_SCHED
}
template <class Epi, class Sched> __device__ __forceinline__ void gemm_phase(LAS unsigned char* lds, const Sched& S, const Epi& E) { gemm_phase_t<false, Epi, Sched>(lds, S, E); }
}

constexpr size_t MiB = 1u << 20;
constexpr size_t WS_RSTD_MIX = 1 * MiB, WS_RSTD_FFN = 1 * MiB + 65536, WS_TOKSLOT = 1 * MiB + 131072;
constexpr size_t WS_PART = 2 * MiB, WS_ROWTOK = 3 * MiB, WS_ROWW = 4 * MiB, WS_ROWRSTD = 5 * MiB, WS_WR = 6 * MiB;
constexpr size_t WS_WIN_T = 8 * MiB, WS_WA_T = 20 * MiB, WS_WP_T = 21 * MiB, WS_WC_T = 22 * MiB, WS_WO_T = 23 * MiB, WS_WQ_T = 25 * MiB, WS_WXO_T = 27 * MiB;
constexpr size_t WS_WGU_T = 29 * MiB, WS_WD_T = 45 * MiB;
constexpr size_t WS_KV = 53 * MiB;
constexpr size_t WS_XB = 69 * MiB, WS_AACT = 69 * MiB, WS_PIN = 85 * MiB;
constexpr size_t WS_ABUF = 101 * MiB, WS_UBUF = 117 * MiB, WS_CXC = 133 * MiB, WS_CB = 149 * MiB, WS_MERGED = 101 * MiB, WS_ACT = 101 * MiB;
constexpr size_t WS_G = 165 * MiB, WS_WKV_T = 165 * MiB, WS_MEMB = 181 * MiB, WS_Q = 165 * MiB, WS_O = 197 * MiB, WS_Y = 165 * MiB;
constexpr size_t WS_CTL = 262 * MiB, CTL_BYTES = 1 * MiB, WS_END = 263 * MiB;
constexpr int CW_BAR = 4096;
constexpr int CW_ECNT = 8192;

struct Args {
    const float* in[28];
    float* out; unsigned char* ws;
    int ph_lo, ph_hi, layer, flags;
};
struct Frame {
    LAS unsigned char* lds; volatile LAS unsigned* MISC; unsigned* ctl;
    int tid, lane, wave, vcu, G;
    unsigned char* ws;
};
constexpr int PTAB_OFF = CTRL_OFF + 2048;
__device__ __forceinline__ const float* inptr(const Frame& F, int i) {
    const unsigned long long v = ((const LAS unsigned long long*)(F.lds + PTAB_OFF))[i];
    const unsigned lo = __builtin_amdgcn_readfirstlane((unsigned)v), hi = __builtin_amdgcn_readfirstlane((unsigned)(v >> 32));
    return (const float*)(((unsigned long long)hi << 32) | lo);
}
__device__ __forceinline__ float wave_sum(float v) {
#pragma unroll
    for (int o = 1; o < 64; o <<= 1) v += __shfl_xor(v, o);
    return v;
}

__device__ __forceinline__ int p8_logical(int p) { return (p & ~31) | (((p >> 2) & 3) << 3) | (((p >> 4) & 1) << 2) | (p & 3); }
struct ColRef { const float* p; int ld; float scale; };
template <class MapF>
__device__ __forceinline__ void prep_item(const MapF& cref, const float* gain, bf16_t* WT, int ldw, int k0, int p0, LAS float* scr, int lane) {
    const ColRef cr = cref(p0 + (lane & 31));
#pragma unroll 8
    for (int i = 0; i < 32; ++i) { const int kk = 2 * i + (lane >> 5); float v = cr.p[(size_t)(k0 + kk) * cr.ld] * cr.scale; if (gain) v *= gain[k0 + kk]; scr[kk * 33 + (lane & 31)] = v; }
    asm volatile("s_waitcnt lgkmcnt(0)" ::: "memory");
    const int c = lane & 7;
#pragma unroll
    for (int j = 0; j < 4; ++j) { const int n = (lane >> 3) + 8 * j; const LAS float* s = scr + (8 * c) * 33 + n;
        u32x4 o; o.x = pk2(s[0 * 33], s[1 * 33]); o.y = pk2(s[2 * 33], s[3 * 33]); o.z = pk2(s[4 * 33], s[5 * 33]); o.w = pk2(s[6 * 33], s[7 * 33]);
        *(u32x4*)(WT + (size_t)(p0 + n) * ldw + k0 + 8 * c) = o; }
    asm volatile("s_waitcnt lgkmcnt(0)" ::: "memory");
}
struct MapPlain { const float* W; int ld; int off; __device__ ColRef operator()(int p) const { return ColRef{W + off + p8_logical(p), ld, 1.f}; } };
struct MapNatural { const float* W; int ld; int off; __device__ ColRef operator()(int p) const { return ColRef{W + off + p, ld, 1.f}; } };
struct MapWin { const float* W; __device__ ColRef operator()(int p) const {
    const int L = p8_logical(p), tile = L >> 8, q8 = (L & 255) >> 3, w = L & 7; int col;
    if (tile < 4) col = (w < 4 ? 0 : 512) + 128 * tile + 4 * q8 + (w & 3);
    else if (tile < 6) col = L;
    else if (tile < 10) col = (w < 4 ? 1536 : 2560) + 128 * (tile - 6) + 4 * q8 + (w & 3);
    else if (tile < 12) col = L - 512;
    else col = L;
    return ColRef{W + col, 6144, 1.f}; } };
struct MapPool { const float* W; const float* ps; __device__ ColRef operator()(int p) const {
    const int n = p8_logical(p); return ColRef{W + (size_t)(n >> 8) * 128 * 256 + (n & 255), 256, ps[n]}; } };
struct MapGU { const float* Wg; long du; __device__ ColRef operator()(int p) const {
    const int L = p8_logical(p), tile = L >> 8, q8 = (L & 255) >> 3, w = L & 7; const int ch = 128 * tile + 4 * q8 + (w & 3);
    return ColRef{Wg + (w < 4 ? 0l : du) + ch, 256, 1.f}; } };

enum { I_X = 0, I_MEM, I_NORM_MIX_G, I_W_IN, I_CONV_A_W, I_CONV_A_B, I_LN_A_G, I_LN_A_B, I_W_A_OUT, I_W_POOL, I_POOL_SCALE, I_CONV_C_W, I_W_C_OUT, I_W_O,
       I_NORM_X_G, I_NORM_MEM_G, I_W_XQ, I_W_XKV, I_W_XO, I_NORM_FFN_G, I_W_RG, I_B_RG, I_W_RE, I_B_RE, I_W_E_GATE, I_W_E_UP, I_W_E_DOWN, I_NORM_F_G };

__device__ __forceinline__ void row_rstd_bf16(const float* xrow, bf16_t* orow, float* rstd_out, bool normalise, int lane) {
    const f32x4* xr = (const f32x4*)xrow + lane;
    f32x4 v[4]; float s = 0.f;
#pragma unroll
    for (int j = 0; j < 4; ++j) { v[j] = xr[64 * j]; s += (v[j].x * v[j].x + v[j].y * v[j].y) + (v[j].z * v[j].z + v[j].w * v[j].w); }
    const float rstd = rsqrtf(wave_sum(s) * (1.f / DM) + EPS);
    if (rstd_out && lane == 0) *rstd_out = rstd;
    const float sc = normalise ? rstd : 1.f;
    u32x2* o8 = (u32x2*)orow + lane;
#pragma unroll
    for (int j = 0; j < 4; ++j) { u32x2 w; w.x = pk2(v[j].x * sc, v[j].y * sc); w.y = pk2(v[j].z * sc, v[j].w * sc); o8[64 * j] = w; }
}

__device__ __forceinline__ void phase_prep(Frame& F, int l, const float* xsrc, bool do_mem, int kvmask) {
    LAS float* scr = (LAS float*)(F.lds + F.wave * 16384);
    const int gw = F.vcu * NWAVES + F.wave, NGW = F.G * NWAVES, lane = F.lane;
    unsigned char* ws = F.ws;
    const float* g_mix = inptr(F, I_NORM_MIX_G) + l * DM; const float* g_x = inptr(F, I_NORM_X_G) + l * DM; const float* g_ffn = inptr(F, I_NORM_FFN_G) + l * DM;
    constexpr int N_WIN = 16 * 192, N_WA = 8 * 32, N_WP = 2 * 32, N_WC = 8 * 32, N_SQ = 16 * 32, N_GU = 16 * 16, N_D = 4 * 32;
    constexpr int N_FIXED = N_WIN + N_WA + N_WP + N_WC + 3 * N_SQ + 16 * N_GU + 16 * N_D;
    const int n_kv = 2 * N_SQ;
    const int total = N_FIXED + ((kvmask & 1) ? n_kv : 0) + ((kvmask & 2) ? n_kv : 0);
    for (int it = gw; it < total; it += NGW) {
        int r = it;
        if (r < N_WIN) { MapWin mp{inptr(F, I_W_IN) + (size_t)l * DM * 6144}; prep_item(mp, g_mix, (bf16_t*)(ws + WS_WIN_T), 1024, 64 * (r / 192), 32 * (r % 192), scr, lane); continue; } r -= N_WIN;
        if (r < N_WA) { MapPlain mp{inptr(F, I_W_A_OUT) + (size_t)l * 512 * DM, DM, 0}; prep_item(mp, nullptr, (bf16_t*)(ws + WS_WA_T), 512, 64 * (r / 32), 32 * (r % 32), scr, lane); continue; } r -= N_WA;
        if (r < N_WP) { MapPool mp{inptr(F, I_W_POOL) + (size_t)l * 4 * 128 * 256, inptr(F, I_POOL_SCALE) + l * DM}; prep_item(mp, nullptr, (bf16_t*)(ws + WS_WP_T), 512, 64 * (r / 32), 32 * (r % 32), scr, lane); continue; } r -= N_WP;
        if (r < N_WC) { MapPlain mp{inptr(F, I_W_C_OUT) + (size_t)l * 512 * DM, DM, 0}; prep_item(mp, nullptr, (bf16_t*)(ws + WS_WC_T), 512, 64 * (r / 32), 32 * (r % 32), scr, lane); continue; } r -= N_WC;
        if (r < N_SQ) { MapPlain mp{inptr(F, I_W_O) + (size_t)l * DM * DM, DM, 0}; prep_item(mp, nullptr, (bf16_t*)(ws + WS_WO_T), 1024, 64 * (r / 32), 32 * (r % 32), scr, lane); continue; } r -= N_SQ;
        if (r < N_SQ) { MapPlain mp{inptr(F, I_W_XQ) + (size_t)l * DM * DM, DM, 0}; prep_item(mp, g_x, (bf16_t*)(ws + WS_WQ_T), 1024, 64 * (r / 32), 32 * (r % 32), scr, lane); continue; } r -= N_SQ;
        if (r < N_SQ) { MapPlain mp{inptr(F, I_W_XO) + (size_t)l * DM * DM, DM, 0}; prep_item(mp, nullptr, (bf16_t*)(ws + WS_WXO_T), 1024, 64 * (r / 32), 32 * (r % 32), scr, lane); continue; } r -= N_SQ;
        if (r < 16 * N_GU) { const int e = r / N_GU, q = r % N_GU; const size_t eo = ((size_t)l * 16 + e) * DM * 256;
            const float* wg_ = inptr(F, I_W_E_GATE); MapGU mp{wg_ + eo, (long)(inptr(F, I_W_E_UP) - wg_)}; prep_item(mp, g_ffn, (bf16_t*)(ws + WS_WGU_T) + (size_t)e * 512 * 1024, 1024, 64 * (q / 16), 32 * (q % 16), scr, lane); continue; } r -= 16 * N_GU;
        if (r < 16 * N_D) { const int e = r / N_D, q = r % N_D; const size_t eo = ((size_t)l * 16 + e) * 256 * DM;
            MapPlain mp{inptr(F, I_W_E_DOWN) + eo, DM, 0}; prep_item(mp, nullptr, (bf16_t*)(ws + WS_WD_T) + (size_t)e * 1024 * 256, 256, 64 * (q / 32), 32 * (q % 32), scr, lane); continue; } r -= 16 * N_D;
        int kl = 0; if ((kvmask & 1) && r >= n_kv) { r -= n_kv; kl = 1; } else if (!(kvmask & 1)) kl = 1;
        const float* wkv = inptr(F, I_W_XKV) + (size_t)kl * DM * 2048; const float* g_mem = inptr(F, I_NORM_MEM_G) + kl * DM;
        bf16_t* dst = (bf16_t*)(ws + WS_WKV_T) + (size_t)kl * 2 * DM * DM;
        if (r < N_SQ) { MapPlain mp{wkv, 2048, 0}; prep_item(mp, g_mem, dst, 1024, 64 * (r / 32), 32 * (r % 32), scr, lane); }
        else { r -= N_SQ; MapNatural mp{wkv, 2048, 1024}; prep_item(mp, g_mem, dst + (size_t)DM * DM, 1024, 64 * (r / 32), 32 * (r % 32), scr, lane); }
    }
    for (int i = gw * 64 + lane; i < 20 * DM; i += NGW * 64) { const int j = i / DM, k = i % DM;
        const float w = (j < 4) ? inptr(F, I_W_RG)[(size_t)l * DM * 4 + k * 4 + j] : inptr(F, I_W_RE)[(size_t)l * DM * 16 + k * 16 + (j - 4)];
        ((float*)(ws + WS_WR))[i] = w * g_ffn[k]; }
    if (xsrc) for (int m = gw; m < NTOK; m += NGW) row_rstd_bf16(xsrc + (size_t)m * DM, (bf16_t*)(ws + WS_XB) + (size_t)m * DM, (float*)(ws + WS_RSTD_MIX) + m, false, lane);
    if (do_mem) for (int m = gw; m < 2048; m += NGW) row_rstd_bf16(inptr(F, I_MEM) + (size_t)m * DM, (bf16_t*)(ws + WS_MEMB) + (size_t)m * DM, nullptr, true, lane);
}

struct SchedGrid {
    const unsigned char* ws; unsigned A, B; unsigned lda, ldb; int nM, nN, nt, G, c;
    __device__ __forceinline__ bool next(int i, g8::Unit& u) const {
        int pm, pn; if (!g8::static_tile(nM, nN, G, c, i, pm, pn)) return false;
        u.A = A + (unsigned)pm * 256u * lda; u.B = B + (unsigned)pn * 256u * ldb; u.nt = nt; u.pm = pm; u.pn = pn; u.kind = 0; return true;
    }
};

struct EpiResid {
    const float* Xin; float* X; bf16_t* XB; float* part;
    __device__ __forceinline__ void operator()(f32x4 (&acc)[2][2][4][2], const g8::Unit& u, int wr, int wc, int fr, int fq) const {
#pragma unroll
        for (int ai = 0; ai < 2; ++ai)
#pragma unroll
            for (int m = 0; m < 4; ++m) {
                const int row = u.pm * 256 + ai * 128 + wr * 64 + m * 16 + fr; float ss = 0.f;
#pragma unroll
                for (int bj = 0; bj < 2; ++bj) {
                    const size_t off = (size_t)row * DM + u.pn * 256 + bj * 128 + wc * 32 + 8 * fq;
                    const f32x4 x0 = *(const f32x4*)(Xin + off) + acc[ai][bj][m][0], x1 = *(const f32x4*)(Xin + off + 4) + acc[ai][bj][m][1];
                    *(f32x4*)(X + off) = x0; *(f32x4*)(X + off + 4) = x1;
                    if (XB) { u32x4 w; w.x = pk2(x0[0], x0[1]); w.y = pk2(x0[2], x0[3]); w.z = pk2(x1[0], x1[1]); w.w = pk2(x1[2], x1[3]); *(u32x4*)(XB + off) = w; }
                    ss += (x0[0] * x0[0] + x0[1] * x0[1]) + (x0[2] * x0[2] + x0[3] * x0[3]) + (x1[0] * x1[0] + x1[1] * x1[1]) + (x1[2] * x1[2] + x1[3] * x1[3]);
                }
                if (part) { ss += __shfl_xor(ss, 16); ss += __shfl_xor(ss, 32); if (fq == 0) part[(size_t)row * 16 + u.pn * 4 + wc] = ss; }
            }
    }
};


struct EpiInProj {
    const float* rstd; bf16_t *Abuf, *Ubuf, *CXC, *CB, *G;
    __device__ __forceinline__ void operator()(f32x4 (&acc)[2][2][4][2], const g8::Unit& u, int wr, int wc, int fr, int fq) const {
        const int pn = u.pn;
#pragma unroll
        for (int ai = 0; ai < 2; ++ai)
#pragma unroll
            for (int m = 0; m < 4; ++m) {
                const int row = u.pm * 256 + ai * 128 + wr * 64 + m * 16 + fr; const float s = rstd[row];
#pragma unroll
                for (int bj = 0; bj < 2; ++bj) {
                    const f32x4 v0 = acc[ai][bj][m][0] * s, v1 = acc[ai][bj][m][1] * s;
                    const int c8 = bj * 128 + wc * 32 + 8 * fq;
                    if (pn < 4 || (pn >= 6 && pn < 10)) {
                        f32x4 r;
                        if (pn < 4) { r[0] = v0[0] * sigm(v1[0]); r[1] = v0[1] * sigm(v1[1]); r[2] = v0[2] * sigm(v1[2]); r[3] = v0[3] * sigm(v1[3]); }
                        else r = v0 * v1;
                        bf16_t* dst = (pn < 4) ? Abuf + (size_t)row * 512 + 128 * pn + (c8 >> 1) : CXC + (size_t)row * 512 + 128 * (pn - 6) + (c8 >> 1);
                        u32x2 w; w.x = pk2(r[0], r[1]); w.y = pk2(r[2], r[3]); *(u32x2*)dst = w;
                    } else {
                        f32x4 a = v0, b = v1; bf16_t* dst;
                        if (pn < 6) dst = Ubuf + (size_t)row * 512 + 256 * (pn - 4) + c8;
                        else if (pn < 12) dst = CB + (size_t)row * 512 + 256 * (pn - 10) + c8;
                        else { dst = G + (size_t)row * 3072 + 256 * (pn - 12) + c8;
                            a[0] = sigm(a[0]); a[1] = sigm(a[1]); a[2] = sigm(a[2]); a[3] = sigm(a[3]); b[0] = sigm(b[0]); b[1] = sigm(b[1]); b[2] = sigm(b[2]); b[3] = sigm(b[3]); }
                        u32x4 w; w.x = pk2(a[0], a[1]); w.y = pk2(a[2], a[3]); w.z = pk2(b[0], b[1]); w.w = pk2(b[2], b[3]); *(u32x4*)dst = w;
                    }
                }
            }
    }
};

struct SchedMerge {
    const unsigned char* ws; unsigned Aact, Pin, Cact, Wa, Wp, Wc; unsigned lda, ldb; int G, c;
    __device__ __forceinline__ bool next(int i, g8::Unit& u) const {
        const int round = i / 3, kind = i - 3 * round; int pm, pn; if (!g8::static_tile(64, 4, G, c, round, pm, pn)) return false;
        const unsigned ao = (unsigned)pm * 256u * 1024u, bo = (unsigned)pn * 256u * 1024u;
        if (kind == 0) { u.A = Aact + ao; u.B = Wa + bo; u.nt = 8; }
        else if (kind == 1) { u.A = Pin + ao + (unsigned)pn * 256u; u.B = Wp + bo; u.nt = 2; }
        else { u.A = Cact + ao; u.B = Wc + bo; u.nt = 8; }
        u.pm = pm; u.pn = pn; u.kind = kind; return true;
    }
};
struct EpiMerge {
    const bf16_t* G; bf16_t* M;
    __device__ __forceinline__ void operator()(f32x4 (&acc)[2][2][4][2], const g8::Unit& u, int wr, int wc, int fr, int fq) const {
        const int kind = u.kind;
#pragma unroll
        for (int ai = 0; ai < 2; ++ai)
#pragma unroll
            for (int m = 0; m < 4; ++m) {
                const int row = u.pm * 256 + ai * 128 + wr * 64 + m * 16 + fr;
#pragma unroll
                for (int bj = 0; bj < 2; ++bj) {
                    const int col = u.pn * 256 + bj * 128 + wc * 32 + 8 * fq;
                    const u32x4 g = *(const u32x4*)(G + (size_t)row * 3072 + kind * 1024 + col);
                    f32x4 r0, r1;
                    r0[0] = bf_lo(g.x) * acc[ai][bj][m][0][0]; r0[1] = bf_hi(g.x) * acc[ai][bj][m][0][1]; r0[2] = bf_lo(g.y) * acc[ai][bj][m][0][2]; r0[3] = bf_hi(g.y) * acc[ai][bj][m][0][3];
                    r1[0] = bf_lo(g.z) * acc[ai][bj][m][1][0]; r1[1] = bf_hi(g.z) * acc[ai][bj][m][1][1]; r1[2] = bf_lo(g.w) * acc[ai][bj][m][1][2]; r1[3] = bf_hi(g.w) * acc[ai][bj][m][1][3];
                    bf16_t* mp = M + (size_t)row * 1024 + col;
                    if (kind != 0) { const u32x4 o = *(const u32x4*)mp;
                        r0[0] += bf_lo(o.x); r0[1] += bf_hi(o.x); r0[2] += bf_lo(o.y); r0[3] += bf_hi(o.y); r1[0] += bf_lo(o.z); r1[1] += bf_hi(o.z); r1[2] += bf_lo(o.w); r1[3] += bf_hi(o.w); }
                    u32x4 w; w.x = pk2(r0[0], r0[1]); w.y = pk2(r0[2], r0[3]); w.z = pk2(r1[0], r1[1]); w.w = pk2(r1[2], r1[3]); *(u32x4*)mp = w;
                }
            }
    }
};

#define OPQ(p) asm volatile("" : "+v"(p))
template <int W> __device__ __forceinline__ void pool_half(const bf16_t* U, bf16_t* P, int t0, int c) {
    float h0[W], h1[W];
    const bf16_t* up = U + (ptrdiff_t)(t0 - W + 1) * 512 + c;
#pragma unroll
    for (int j = 0; j < W; ++j) { const int t = t0 - W + 1 + j; unsigned w = 0u; if (t >= 0 && j < W - 1) w = *(const unsigned*)up; h0[j] = bf_lo(w); h1[j] = bf_hi(w); if (j < W - 1) { up += 512; OPQ(up); } }
    bf16_t* pp = P + (size_t)t0 * 512 + c;
#pragma unroll
    for (int tt = 0; tt < 32; ++tt) {
        const int t = t0 + tt; const unsigned w = *(const unsigned*)up; up += 512; OPQ(up);
        h0[(tt + W - 1) % W] = bf_lo(w); h1[(tt + W - 1) % W] = bf_hi(w);
        float s0 = 0.f, s1 = 0.f;
#pragma unroll
        for (int j = 0; j < W; ++j) { s0 += h0[j]; s1 += h1[j]; }
        const float inv = 1.f / (float)((t + 1 < W) ? (t + 1) : W);
        *(unsigned*)pp = pk2(s0 * inv - bf_lo(w), s1 * inv - bf_hi(w)); pp += 512; OPQ(pp);
    }
}
__device__ __forceinline__ void phase_p2(Frame& F, int l) {
    const int tid = F.tid, half = __builtin_amdgcn_readfirstlane(tid >> 8), c = 2 * (tid & 255), lane = F.lane, wave = F.wave;
    unsigned char* ws = F.ws;
    const bf16_t* Abuf = (const bf16_t*)(ws + WS_ABUF); const bf16_t* Ubuf = (const bf16_t*)(ws + WS_UBUF); const bf16_t* CXC = (const bf16_t*)(ws + WS_CXC); bf16_t* CB = (bf16_t*)(ws + WS_CB);
    bf16_t* Aact = (bf16_t*)(ws + WS_AACT); bf16_t* Pin = (bf16_t*)(ws + WS_PIN);
    const float* cw = inptr(F, I_CONV_A_W) + l * 31 * 512; const float* cb = inptr(F, I_CONV_A_B) + l * 512;
    const float* lg = inptr(F, I_LN_A_G) + l * 512; const float* lb = inptr(F, I_LN_A_B) + l * 512; const float* ccw = inptr(F, I_CONV_C_W) + l * 3 * 512;
    LAS float* V = (LAS float*)F.lds;
    for (int seg = blockIdx.x; seg < NTOK / 64; seg += F.G) {
        const int b = seg >> 5, ts = (seg & 31) * 64;
        const size_t seq0 = (size_t)b * SEQ;
        const int t0 = ts + 32 * half;
        {
            const int ch = tid;
            float w[31];
#pragma unroll
            for (int k = 0; k < 31; ++k) w[k] = cw[k * 512 + ch];
            const float bias = cb[ch];
            float x[31];
#pragma unroll
            for (int k = 0; k < 31; ++k) x[k] = 0.f;
            const bf16_t* src = Abuf + ((ptrdiff_t)seq0 + ts - 30) * 512 + ch;
            LAS float* vp = V + ch - 30 * 512;
#pragma unroll 1
            for (int it = 0; it < 4; ++it) {
#pragma unroll
                for (int j = 0; j < 31; ++j) {
                    const int st = it * 31 + j;
                    if (st < 94) {
                        unsigned short hv = 0; if (ts - 30 + st >= 0) hv = *src;
                        src += 512;
                        x[j] = __uint_as_float((unsigned)hv << 16);
                        if (st >= 30) {
                            float a0 = bias;
#pragma unroll
                            for (int k = 0; k < 31; ++k) a0 += w[k] * x[(j + 1 + k) % 31];
                            vp[st * 512] = a0;
                        }
                    }
                }
            }
        }
        {
            const bf16_t* U = Ubuf + seq0 * 512; bf16_t* P = Pin + seq0 * 512; const int g = __builtin_amdgcn_readfirstlane((tid & 255) >> 6);
            if (g == 0) pool_half<2>(U, P, t0, c); else if (g == 1) pool_half<4>(U, P, t0, c); else if (g == 2) pool_half<8>(U, P, t0, c); else pool_half<16>(U, P, t0, c);
        }
        {
            const f32x2 k0 = *(const f32x2*)(ccw + c), k1 = *(const f32x2*)(ccw + 512 + c), k2 = *(const f32x2*)(ccw + 1024 + c);
            const bf16_t* X = CXC + seq0 * 512 + c; bf16_t* Bp = CB + (seq0 + t0) * 512 + c;
            unsigned wm2 = (t0 - 2 >= 0) ? *(const unsigned*)(X + (ptrdiff_t)(t0 - 2) * 512) : 0u, wm1 = (t0 - 1 >= 0) ? *(const unsigned*)(X + (ptrdiff_t)(t0 - 1) * 512) : 0u;
            const bf16_t* xp = X + (size_t)t0 * 512;
#pragma unroll 4
            for (int tt = 0; tt < 32; ++tt) {
                const unsigned wv = *(const unsigned*)xp; const unsigned cbw = *(const unsigned*)Bp;
                const float v0 = k0.x * bf_lo(wm2) + k1.x * bf_lo(wm1) + k2.x * bf_lo(wv), v1 = k0.y * bf_hi(wm2) + k1.y * bf_hi(wm1) + k2.y * bf_hi(wv);
                *(unsigned*)Bp = pk2(bf_lo(cbw) * v0, bf_hi(cbw) * v1);
                wm2 = wm1; wm1 = wv; xp += 512; Bp += 512;
            }
        }
        __syncthreads();
        {
            const f32x4 g0 = *(const f32x4*)(lg + 8 * lane), g1 = *(const f32x4*)(lg + 8 * lane + 4), b0 = *(const f32x4*)(lb + 8 * lane), b1 = *(const f32x4*)(lb + 8 * lane + 4);
            for (int i = 0; i < 8; ++i) {
                const int tok = wave * 8 + i;
                const f32x4 v0 = *(const LAS f32x4*)(V + tok * 512 + 8 * lane), v1 = *(const LAS f32x4*)(V + tok * 512 + 8 * lane + 4);
                const float mu = wave_sum((v0[0] + v0[1]) + (v0[2] + v0[3]) + (v1[0] + v1[1]) + (v1[2] + v1[3])) * (1.f / 512.f);
                const f32x4 d0 = v0 - mu, d1 = v1 - mu;
                const float var = wave_sum((d0[0] * d0[0] + d0[1] * d0[1]) + (d0[2] * d0[2] + d0[3] * d0[3]) + (d1[0] * d1[0] + d1[1] * d1[1]) + (d1[2] * d1[2] + d1[3] * d1[3])) * (1.f / 512.f);
                const float rs = rsqrtf(var + EPS);
                f32x4 y0 = d0 * rs * g0 + b0, y1 = d1 * rs * g1 + b1;
                y0[0] *= sigm(y0[0]); y0[1] *= sigm(y0[1]); y0[2] *= sigm(y0[2]); y0[3] *= sigm(y0[3]); y1[0] *= sigm(y1[0]); y1[1] *= sigm(y1[1]); y1[2] *= sigm(y1[2]); y1[3] *= sigm(y1[3]);
                u32x4 w; w.x = pk2(y0[0], y0[1]); w.y = pk2(y0[2], y0[3]); w.z = pk2(y1[0], y1[1]); w.w = pk2(y1[2], y1[3]);
                *(u32x4*)(Aact + (seq0 + ts + tok) * 512 + 8 * lane) = w;
            }
        }
        __syncthreads();
    }
}


struct SchedKV {
    const unsigned char* ws; unsigned memb, wkv; unsigned lda, ldb; int mask, G, c;
    __device__ __forceinline__ bool next(int i, g8::Unit& u) const {
        int L = i * G + c; const int nl = ((mask & 1) ? 1 : 0) + ((mask & 2) ? 1 : 0); if (L >= 64 * nl) return false;
        int kl = (mask & 1) ? 0 : 1; if (L >= 64) { L -= 64; kl = 1; }
        const unsigned w = wkv + (unsigned)kl * 2u * 1024u * 2048u;
        if (L < 32) { u.pm = L >> 2; u.pn = L & 3; u.A = memb + (unsigned)u.pm * 256u * 2048u; u.B = w + (unsigned)u.pn * 256u * 2048u; u.kind = 2 * kl; }
        else { L -= 32; u.pm = L >> 3; u.pn = L & 7; u.A = w + 1024u * 2048u + (unsigned)u.pm * 256u * 2048u; u.B = memb + (unsigned)u.pn * 256u * 2048u; u.kind = 2 * kl + 1; }
        u.nt = 16; return true;
    }
};
struct EpiKV {
    bf16_t* KV;
    __device__ __forceinline__ void operator()(f32x4 (&acc)[2][2][4][2], const g8::Unit& u, int wr, int wc, int fr, int fq) const {
        bf16_t* base = KV + (size_t)(u.kind >> 1) * 4 * 1024 * 1024;
        const int sfq = (fq == 1) ? 2 : (fq == 2 ? 1 : fq);
#pragma unroll
        for (int ai = 0; ai < 2; ++ai)
#pragma unroll
            for (int m = 0; m < 4; ++m) {
                const int row = u.pm * 256 + ai * 128 + wr * 64 + m * 16 + fr;
#pragma unroll
                for (int bj = 0; bj < 2; ++bj) {
                    if ((u.kind & 1) == 0) {
                        const f32x4 a = acc[ai][bj][m][0], b = acc[ai][bj][m][1];
                        u32x4 w; w.x = pk2(a[0], a[1]); w.y = pk2(a[2], a[3]); w.z = pk2(b[0], b[1]); w.w = pk2(b[2], b[3]);
                        *(u32x4*)(base + (size_t)row * 1024 + u.pn * 256 + bj * 128 + wc * 32 + 8 * fq) = w;
                    } else {
#pragma unroll
                        for (int n = 0; n < 2; ++n) { const f32x4 a = acc[ai][bj][m][n]; u32x2 w; w.x = pk2(a[0], a[1]); w.y = pk2(a[2], a[3]);
                            *(u32x2*)(base + (size_t)2048 * 1024 + ((size_t)u.pn * 1024 + row) * 256 + bj * 128 + wc * 32 + 16 * n + 4 * sfq) = w; }
                    }
                }
            }
    }
};
struct EpiQ {
    const float* part; bf16_t* Q;
    __device__ __forceinline__ void operator()(f32x4 (&acc)[2][2][4][2], const g8::Unit& u, int wr, int wc, int fr, int fq) const {
#pragma unroll
        for (int ai = 0; ai < 2; ++ai)
#pragma unroll
            for (int m = 0; m < 4; ++m) {
                const int row = u.pm * 256 + ai * 128 + wr * 64 + m * 16 + fr;
                const f32x4 pv = *(const f32x4*)(part + (size_t)row * 16 + 4 * fq);
                float ss = (pv[0] + pv[1]) + (pv[2] + pv[3]); ss += __shfl_xor(ss, 16); ss += __shfl_xor(ss, 32);
                const float s = rsqrtf(ss * (1.f / DM) + EPS) * (0.0625f * 1.4426950408889634f);
#pragma unroll
                for (int bj = 0; bj < 2; ++bj) {
                    const f32x4 a = acc[ai][bj][m][0] * s, b = acc[ai][bj][m][1] * s;
                    u32x4 w; w.x = pk2(a[0], a[1]); w.y = pk2(a[2], a[3]); w.z = pk2(b[0], b[1]); w.w = pk2(b[2], b[3]);
                    *(u32x4*)(Q + (size_t)row * 1024 + u.pn * 256 + bj * 128 + wc * 32 + 8 * fq) = w;
                }
            }
    }
};
constexpr int ATT_ROWB = 528; static_assert(256 * ATT_ROWB <= CTRL_OFF, "attention tile image must stay below the LDS control area");
__device__ __forceinline__ void att_fill(LAS unsigned char* lds, const bf16_t* src, size_t row_stride_el, int tid) {
    const bf16_t* gp = src + (size_t)(tid >> 5) * row_stride_el + (tid & 31) * 8;
    LAS unsigned char* lp = lds + (tid >> 5) * ATT_ROWB + (tid & 31) * 16;
#pragma unroll
    for (int p0 = 0; p0 < 16; p0 += 4) {
        u32x4 v[4];
#pragma unroll
        for (int j = 0; j < 4; ++j) { v[j] = *(const u32x4*)gp; gp += 16 * row_stride_el; asm volatile("" : "+v"(gp)); }
#pragma unroll
        for (int j = 0; j < 4; ++j) { *(LAS u32x4*)lp = v[j]; lp += 16 * ATT_ROWB; asm volatile("" : "+v"(lp)); }
    }
}
__device__ __forceinline__ void phase_attn(Frame& F, int l) {
    const int tid = F.tid, lane = F.lane, wave = F.wave, r = lane & 31, hh = lane >> 5;
    const bf16_t* Q = (const bf16_t*)(F.ws + WS_Q); bf16_t* O = (bf16_t*)(F.ws + WS_O);
    const bf16_t* Kb = (const bf16_t*)(F.ws + WS_KV) + (size_t)l * 4 * 1024 * 1024; const bf16_t* Vt = Kb + (size_t)2048 * 1024;
    for (int id = blockIdx.x; id < 256; id += F.G) {
        const int xcd = id & 7, j = id >> 3, pair = xcd * 4 + (j >> 3), qb = j & 7, b = pair >> 2, h = pair & 3;
        const size_t qrow = (size_t)b * SEQ + qb * 256 + wave * 32 + r;
        att_fill(F.lds, Kb + (size_t)b * 256 * 1024 + h * 256, 1024, tid);
        __syncthreads();
        f32x16 acc[8];
        const LAS unsigned char* frag = F.lds + r * ATT_ROWB + hh * 16;
#pragma unroll
        for (int kb = 0; kb < 8; ++kb)
#pragma unroll
            for (int i = 0; i < 16; ++i) acc[kb][i] = 0.f;
        const bf16_t* qp = Q + qrow * 1024 + h * 256 + 8 * hh;
        bf16x8 qn = *(const bf16x8*)qp;
#pragma unroll 1
        for (int s = 0; s < 16; ++s) {
            const bf16x8 q = qn; if (s < 15) qn = *(const bf16x8*)(qp + 16 * (s + 1));
#pragma unroll
            for (int kb = 0; kb < 8; ++kb) { const bf16x8 a = *(const LAS bf16x8*)(frag + kb * 32 * ATT_ROWB + s * 32); acc[kb] = __builtin_amdgcn_mfma_f32_32x32x16_bf16(a, q, acc[kb], 0, 0, 0); }
        }
        float mx = acc[0][0];
#pragma unroll
        for (int kb = 0; kb < 8; ++kb)
#pragma unroll
            for (int i = 0; i < 16; ++i) mx = fmaxf(mx, acc[kb][i]);
        mx = fmaxf(mx, __shfl_xor(mx, 32));
        float sum = 0.f;
#pragma unroll
        for (int kb = 0; kb < 8; ++kb)
#pragma unroll
            for (int i = 0; i < 16; ++i) { const float p = __builtin_amdgcn_exp2f(acc[kb][i] - mx); acc[kb][i] = p; sum += p; }
        sum += __shfl_xor(sum, 32);
        const float inv = 1.f / sum;
        bf16x8 pf[16];
#pragma unroll
        for (int kb = 0; kb < 8; ++kb)
#pragma unroll
            for (int s2 = 0; s2 < 2; ++s2) { u32x4 w; w.x = pk2(acc[kb][8 * s2 + 0], acc[kb][8 * s2 + 1]); w.y = pk2(acc[kb][8 * s2 + 2], acc[kb][8 * s2 + 3]);
                w.z = pk2(acc[kb][8 * s2 + 4], acc[kb][8 * s2 + 5]); w.w = pk2(acc[kb][8 * s2 + 6], acc[kb][8 * s2 + 7]); pf[2 * kb + s2] = __builtin_bit_cast(bf16x8, w); }
        __syncthreads();
        att_fill(F.lds, Vt + ((size_t)b * 1024 + h * 256) * 256, 256, tid);
        __syncthreads();
        bf16_t* orow = O + qrow * 1024 + h * 256 + 4 * hh;
#pragma unroll 1
        for (int db = 0; db < 8; ++db) {
            f32x16 o;
#pragma unroll
            for (int i = 0; i < 16; ++i) o[i] = 0.f;
#pragma unroll
            for (int ks = 0; ks < 16; ++ks) { const bf16x8 a = *(const LAS bf16x8*)(frag + db * 32 * ATT_ROWB + ks * 32); o = __builtin_amdgcn_mfma_f32_32x32x16_bf16(a, pf[ks], o, 0, 0, 0); }
#pragma unroll
            for (int g = 0; g < 4; ++g) { u32x2 w; w.x = pk2(o[4 * g] * inv, o[4 * g + 1] * inv); w.y = pk2(o[4 * g + 2] * inv, o[4 * g + 3] * inv); *(u32x2*)(orow + 32 * db + 8 * g) = w; }
        }
        __syncthreads();
    }
}


constexpr int ECAP = 16384;
constexpr int MW_TP = 16, MW_CNT = 40, MW_TE = 64;
__device__ __forceinline__ void moe_table(Frame& F, int l) {
    if (F.tid < 16) F.MISC[MW_CNT + F.tid] = __hip_atomic_load(F.ctl + CW_ECNT + l * 64 + F.tid, __ATOMIC_RELAXED, __HIP_MEMORY_SCOPE_AGENT);
    __syncthreads();
    if (F.tid == 0) { unsigned a = 0; for (int e = 0; e < 16; ++e) { F.MISC[MW_TP + e] = a; const unsigned nt_ = (F.MISC[MW_CNT + e] + 255u) >> 8; for (unsigned k = 0; k < nt_ && a + k < 144u; ++k) F.MISC[MW_TE + a + k] = (unsigned)e; a += nt_; } F.MISC[MW_TP + 16] = a; }
    __syncthreads();
}
__device__ __forceinline__ int misc_u(volatile LAS unsigned* M, int i) { return __builtin_amdgcn_readfirstlane((int)M[i]); }
__device__ __forceinline__ int moe_expert_of_tile(volatile LAS unsigned* M, int ti) { return misc_u(M, MW_TE + ti); }

__device__ __forceinline__ void route_one(const float (&L)[20], const float (&bias)[20], float rstd, int& eg1, int& eg2, float& w1, float& w2) {
    float lg[4]; int gi = 0; float mg;
#pragma unroll
    for (int j = 0; j < 4; ++j) lg[j] = L[j] * rstd + bias[j];
    mg = lg[0];
#pragma unroll
    for (int j = 1; j < 4; ++j) if (lg[j] > mg) { mg = lg[j]; gi = j; }
    float se = 0.f;
#pragma unroll
    for (int j = 0; j < 4; ++j) se += __expf(lg[j] - mg);
    const float gval = 1.f / se;
    float le[4];
#pragma unroll
    for (int j = 0; j < 4; ++j) { const float a = L[4 + j] * rstd + bias[4 + j], b = L[8 + j] * rstd + bias[8 + j], c = L[12 + j] * rstd + bias[12 + j], d = L[16 + j] * rstd + bias[16 + j];
        le[j] = (gi == 0) ? a : (gi == 1) ? b : (gi == 2) ? c : d; }
    int e1 = 0; float m1 = le[0];
#pragma unroll
    for (int j = 1; j < 4; ++j) if (le[j] > m1) { m1 = le[j]; e1 = j; }
    int e2 = -1; float m2 = -3.0e38f;
#pragma unroll
    for (int j = 0; j < 4; ++j) if (j != e1 && le[j] > m2) { m2 = le[j]; e2 = j; }
    const float p2 = __expf(m2 - m1);
    w1 = gval / (1.f + p2); w2 = gval * p2 / (1.f + p2); eg1 = gi * 4 + e1; eg2 = gi * 4 + e2;
}
__device__ __forceinline__ void phase_router(Frame& F, int l, const float* X) {
    const int tid = F.tid, lane = F.lane, wave = F.wave;
    LAS float* WR = (LAS float*)F.lds;
    LAS unsigned* lcnt = (LAS unsigned*)(F.lds + 81920);
    LAS unsigned* ent = lcnt + 64;
    LAS float* entw = (LAS float*)(ent + 128);
    LAS float* lrstd = entw + 128;
    for (int i = tid; i < 20 * DM / 4; i += NTHREADS) ((LAS f32x4*)WR)[i] = ((const f32x4*)(F.ws + WS_WR))[i];
    float bias[20];
    { const float* brg = inptr(F, I_B_RG) + l * 4; const float* bre = inptr(F, I_B_RE) + l * 16;
#pragma unroll
      for (int j = 0; j < 4; ++j) bias[j] = brg[j];
#pragma unroll
      for (int j = 0; j < 16; ++j) bias[4 + j] = bre[j]; }
    unsigned* gcnt = F.ctl + CW_ECNT + l * 64;
    int* ROWTOK = (int*)(F.ws + WS_ROWTOK); float* ROWW = (float*)(F.ws + WS_ROWW); float* ROWRSTD = (float*)(F.ws + WS_ROWRSTD); unsigned* TOKSLOT = (unsigned*)(F.ws + WS_TOKSLOT);
    for (int chunk = blockIdx.x; chunk < NTOK / 64; chunk += F.G) {
        if (tid < 16) lcnt[tid] = 0u;
        __syncthreads();
        for (int pr = 0; pr < 4; ++pr) {
            const int tl = wave * 8 + 2 * pr; const size_t tokA = (size_t)chunk * 64 + tl;
            const f32x4* ra = (const f32x4*)(X + tokA * DM) + lane; const f32x4* rb = ra + DM / 4;
            f32x4 xa[4], xb[4]; float sa = 0.f, sb = 0.f;
#pragma unroll
            for (int j = 0; j < 4; ++j) { xa[j] = ra[64 * j]; xb[j] = rb[64 * j];
                sa += (xa[j][0] * xa[j][0] + xa[j][1] * xa[j][1]) + (xa[j][2] * xa[j][2] + xa[j][3] * xa[j][3]); sb += (xb[j][0] * xb[j][0] + xb[j][1] * xb[j][1]) + (xb[j][2] * xb[j][2] + xb[j][3] * xb[j][3]); }
            float LA[20], LB[20];
#pragma unroll
            for (int j = 0; j < 20; ++j) { float a = 0.f, b = 0.f;
#pragma unroll
                for (int jj = 0; jj < 4; ++jj) { const f32x4 w = *(const LAS f32x4*)(WR + j * 1024 + 256 * jj + 4 * lane);
                    a += (xa[jj][0] * w[0] + xa[jj][1] * w[1]) + (xa[jj][2] * w[2] + xa[jj][3] * w[3]); b += (xb[jj][0] * w[0] + xb[jj][1] * w[1]) + (xb[jj][2] * w[2] + xb[jj][3] * w[3]); }
                LA[j] = wave_sum(a); LB[j] = wave_sum(b); }
            const float rsa = rsqrtf(wave_sum(sa) * (1.f / DM) + EPS), rsb = rsqrtf(wave_sum(sb) * (1.f / DM) + EPS);
            int a1, a2, b1, b2; float wa1, wa2, wb1, wb2;
            route_one(LA, bias, rsa, a1, a2, wa1, wa2); route_one(LB, bias, rsb, b1, b2, wb1, wb2);
            if (lane == 0) {
                unsigned p;
                p = __hip_atomic_fetch_add(lcnt + a1, 1u, __ATOMIC_RELAXED, __HIP_MEMORY_SCOPE_WORKGROUP); ent[tl * 2 + 0] = ((unsigned)a1 << 16) | p; entw[tl * 2 + 0] = wa1;
                p = __hip_atomic_fetch_add(lcnt + a2, 1u, __ATOMIC_RELAXED, __HIP_MEMORY_SCOPE_WORKGROUP); ent[tl * 2 + 1] = ((unsigned)a2 << 16) | p; entw[tl * 2 + 1] = wa2;
                p = __hip_atomic_fetch_add(lcnt + b1, 1u, __ATOMIC_RELAXED, __HIP_MEMORY_SCOPE_WORKGROUP); ent[tl * 2 + 2] = ((unsigned)b1 << 16) | p; entw[tl * 2 + 2] = wb1;
                p = __hip_atomic_fetch_add(lcnt + b2, 1u, __ATOMIC_RELAXED, __HIP_MEMORY_SCOPE_WORKGROUP); ent[tl * 2 + 3] = ((unsigned)b2 << 16) | p; entw[tl * 2 + 3] = wb2;
                lrstd[tl] = rsa; lrstd[tl + 1] = rsb;
            }
        }
        __syncthreads();
        if (tid < 16) lcnt[16 + tid] = __hip_atomic_fetch_add(gcnt + tid, lcnt[tid], __ATOMIC_RELAXED, __HIP_MEMORY_SCOPE_AGENT);
        __syncthreads();
        if (tid < 128) { const int tl = tid >> 1; const unsigned en = ent[tid], e = en >> 16, pos = lcnt[16 + e] + (en & 0xffffu); const int token = chunk * 64 + tl;
            ROWTOK[e * ECAP + pos] = token; ROWW[e * ECAP + pos] = entw[tid]; ROWRSTD[e * ECAP + pos] = lrstd[tl]; TOKSLOT[token * 2 + (tid & 1)] = (e << 20) | pos; }
        __syncthreads();
    }
}
struct SchedMoe1 {
    const unsigned char* ws; unsigned XB, W; const int* rowtok; volatile LAS unsigned* M; unsigned lda, ldb; int G, c;
    __device__ __forceinline__ bool next(int i, g8::Unit& u) const {
        const int L = i * G + c; if (L >= 2 * misc_u(M, MW_TP + 16)) return false;
        const int ti = L >> 1, pn = L & 1, e = moe_expert_of_tile(M, ti), mt = ti - misc_u(M, MW_TP + e), ne = misc_u(M, MW_CNT + e);
        u.A = XB; u.B = W + ((unsigned)e * 512u + (unsigned)pn * 256u) * 2048u; u.gth = rowtok + e * ECAP + mt * 256; u.nvalid = ne - mt * 256; u.nt = 16; u.pm = ti; u.pn = pn; u.kind = e * ECAP + mt * 256; return true;
    }
};
struct EpiMoe1 {
    const float* roww; const float* rowrstd; bf16_t* ACT;
    __device__ __forceinline__ void operator()(f32x4 (&acc)[2][2][4][2], const g8::Unit& u, int wr, int wc, int fr, int fq) const {
#pragma unroll
        for (int ai = 0; ai < 2; ++ai)
#pragma unroll
            for (int m = 0; m < 4; ++m) {
                const int rr = ai * 128 + wr * 64 + m * 16 + fr; const float s = rowrstd[u.kind + rr], w = roww[u.kind + rr];
#pragma unroll
                for (int bj = 0; bj < 2; ++bj) {
                    const f32x4 g = acc[ai][bj][m][0] * s, up = acc[ai][bj][m][1] * s; f32x4 r;
                    r[0] = g[0] * sigm(g[0]) * up[0] * w; r[1] = g[1] * sigm(g[1]) * up[1] * w; r[2] = g[2] * sigm(g[2]) * up[2] * w; r[3] = g[3] * sigm(g[3]) * up[3] * w;
                    u32x2 o; o.x = pk2(r[0], r[1]); o.y = pk2(r[2], r[3]);
                    *(u32x2*)(ACT + ((size_t)u.pm * 256 + rr) * 256 + 128 * u.pn + ((bj * 128 + wc * 32 + 8 * fq) >> 1)) = o;
                }
            }
    }
};
struct SchedMoe2 {
    const unsigned char* ws; unsigned ACT, W; volatile LAS unsigned* M; unsigned lda, ldb; int G, c;
    __device__ __forceinline__ bool next(int i, g8::Unit& u) const {
        const int L = i * G + c; if (L >= 4 * misc_u(M, MW_TP + 16)) return false;
        const int ti = L >> 2, pn = L & 3, e = moe_expert_of_tile(M, ti);
        u.A = ACT + (unsigned)ti * 256u * 512u; u.B = W + ((unsigned)e * 1024u + (unsigned)pn * 256u) * 512u; u.nt = 4; u.pm = ti; u.pn = pn; u.kind = 0; return true;
    }
};
struct EpiY {
    bf16_t* Y;
    __device__ __forceinline__ void operator()(f32x4 (&acc)[2][2][4][2], const g8::Unit& u, int wr, int wc, int fr, int fq) const {
#pragma unroll
        for (int ai = 0; ai < 2; ++ai)
#pragma unroll
            for (int m = 0; m < 4; ++m) {
                const size_t row = (size_t)u.pm * 256 + ai * 128 + wr * 64 + m * 16 + fr;
#pragma unroll
                for (int bj = 0; bj < 2; ++bj) { const f32x4 a = acc[ai][bj][m][0], b = acc[ai][bj][m][1];
                    u32x4 w; w.x = pk2(a[0], a[1]); w.y = pk2(a[2], a[3]); w.z = pk2(b[0], b[1]); w.w = pk2(b[2], b[3]);
                    *(u32x4*)(Y + row * 1024 + u.pn * 256 + bj * 128 + wc * 32 + 8 * fq) = w; }
            }
    }
};
__device__ __forceinline__ void phase_combine(Frame& F, float* X, bool last) {
    const int gw = F.vcu * NWAVES + F.wave, NGW = F.G * NWAVES, lane = F.lane;
    const unsigned* TOKSLOT = (const unsigned*)(F.ws + WS_TOKSLOT); const bf16_t* Y = (const bf16_t*)(F.ws + WS_Y);
    const float* gf = inptr(F, I_NORM_F_G);
    for (int m = gw; m < NTOK; m += NGW) {
        const unsigned s0 = TOKSLOT[2 * m], s1 = TOKSLOT[2 * m + 1];
        const size_t r0 = (size_t)F.MISC[MW_TP + (s0 >> 20)] * 256 + (s0 & 0xfffffu), r1 = (size_t)F.MISC[MW_TP + (s1 >> 20)] * 256 + (s1 & 0xfffffu);
        f32x4* xr = (f32x4*)(X + (size_t)m * DM) + lane; const u32x2* y0 = (const u32x2*)(Y + r0 * DM) + lane; const u32x2* y1 = (const u32x2*)(Y + r1 * DM) + lane;
        f32x4 v[4]; float ss = 0.f;
#pragma unroll
        for (int j = 0; j < 4; ++j) { const u32x2 a = y0[64 * j], b = y1[64 * j]; f32x4 x = xr[64 * j];
            x[0] += bf_lo(a.x) + bf_lo(b.x); x[1] += bf_hi(a.x) + bf_hi(b.x); x[2] += bf_lo(a.y) + bf_lo(b.y); x[3] += bf_hi(a.y) + bf_hi(b.y);
            v[j] = x; ss += (x[0] * x[0] + x[1] * x[1]) + (x[2] * x[2] + x[3] * x[3]); }
        const float rstd = rsqrtf(wave_sum(ss) * (1.f / DM) + EPS);
        if (last) {
#pragma unroll
            for (int j = 0; j < 4; ++j) { const f32x4 g = *((const f32x4*)gf + lane + 64 * j); xr[64 * j] = v[j] * rstd * g; }
        } else {
            if (lane == 0) ((float*)(F.ws + WS_RSTD_MIX))[m] = rstd;
            u32x2* xb = (u32x2*)((bf16_t*)(F.ws + WS_XB) + (size_t)m * DM) + lane;
#pragma unroll
            for (int j = 0; j < 4; ++j) { xr[64 * j] = v[j]; u32x2 w; w.x = pk2(v[j][0], v[j][1]); w.y = pk2(v[j][2], v[j][3]); xb[64 * j] = w; }
        }
    }
}

enum { PH_PREP = 0, PH_KV, PH_P1, PH_P2, PH_P3, PH_P4, PH_P5, PH_P6, PH_P7, PH_P8, PH_P9, PH_P10, PH_P11, PH_COUNT };

__global__ void __launch_bounds__(NTHREADS, 2) mega(Args args) {
    extern __shared__ __attribute__((aligned(16))) unsigned char lds_raw[];
    Frame F;
    F.lds = (LAS unsigned char*)lds_raw; F.MISC = (volatile LAS unsigned*)(F.lds + MISC_OFF);
    F.tid = threadIdx.x; F.lane = F.tid & 63; F.wave = __builtin_amdgcn_readfirstlane(F.tid >> 6);
    F.G = gridDim.x; { const int bx = blockIdx.x; F.vcu = (F.G % 8 == 0) ? (bx % 8) * (F.G / 8) + bx / 8 : bx; }
    F.ws = args.ws; F.ctl = (unsigned*)(args.ws + WS_CTL);
    for (int u = F.tid; u < (PTAB_OFF - MISC_OFF) / 4; u += NTHREADS) F.MISC[u] = 0u;
    if (F.tid < 28) ((LAS unsigned long long*)(F.lds + PTAB_OFF))[F.tid] = (unsigned long long)args.in[F.tid];
    __syncthreads();
    const bool fused = (args.flags & 8) != 0;
    XcdBarrier bar; bar.bar = F.ctl + CW_BAR; bar.x = 0; bar.st = nullptr;
    if (fused) bar = xcd_barrier_post(F.ctl + CW_BAR, F.MISC + 8);
    const int lo = args.ph_lo, hi = args.ph_hi;
    const int l_lo = fused ? 0 : args.layer, l_hi = fused ? 2 : args.layer + 1;
#define IN(k) (lo <= (k) && (k) < hi)
#define SEAM() do { if (fused) xcd_barrier(bar); LAUNDER(); } while (0)
#define LAUNDER() do { unsigned char* w_ = F.ws; asm volatile("" : "+s"(w_)); F.ws = w_; F.ctl = (unsigned*)(w_ + WS_CTL); int t_ = F.tid; asm volatile("" : "+v"(t_)); F.tid = t_; F.lane = t_ & 63; F.wave = __builtin_amdgcn_readfirstlane(t_ >> 6); } while (0)
#pragma unroll
    for (int l = 0; l < 2; ++l) { if (l < l_lo || l >= l_hi) continue;
    if (IN(PH_PREP) && !(fused && l == 1)) {
        const float* xsrc = (l == 0) ? inptr(F, I_X) : ((args.flags & 2) ? (const float*)args.out : nullptr);
        phase_prep(F, l, xsrc, l == 0 || (args.flags & 4), (args.flags & 1) ? (l == 0 ? 3 : 0) : (1 << l));
        SEAM();
    }
    if (IN(PH_KV) && (l == 0 || !(args.flags & 1))) {
        SchedKV S{F.ws, (unsigned)WS_MEMB, (unsigned)WS_WKV_T, 2048u, 2048u, (args.flags & 1) ? 3 : (1 << l), F.G, (int)blockIdx.x};
        EpiKV E{(bf16_t*)(F.ws + WS_KV)};
        g8::gemm_phase(F.lds, S, E);
        SEAM();
    }
    if (IN(PH_P1)) {
        SchedGrid S{F.ws, (unsigned)WS_XB, (unsigned)WS_WIN_T, 2048u, 2048u, 64, 24, 16, F.G, (int)blockIdx.x};
        EpiInProj E{(const float*)(F.ws + WS_RSTD_MIX), (bf16_t*)(F.ws + WS_ABUF), (bf16_t*)(F.ws + WS_UBUF), (bf16_t*)(F.ws + WS_CXC), (bf16_t*)(F.ws + WS_CB), (bf16_t*)(F.ws + WS_G)};
        g8::gemm_phase(F.lds, S, E);
        SEAM();
    }
    if (IN(PH_P2)) { phase_p2(F, l); SEAM(); }
    if (IN(PH_P3)) {
        SchedMerge S{F.ws, (unsigned)WS_AACT, (unsigned)WS_PIN, (unsigned)WS_CB, (unsigned)WS_WA_T, (unsigned)WS_WP_T, (unsigned)WS_WC_T, 1024u, 1024u, F.G, (int)blockIdx.x};
        EpiMerge E{(const bf16_t*)(F.ws + WS_G), (bf16_t*)(F.ws + WS_MERGED)};
        g8::gemm_phase(F.lds, S, E);
        SEAM();
    }
    if (IN(PH_P4)) {
        const float* xin = (l == 0) ? inptr(F, I_X) : args.out;
        SchedGrid S{F.ws, (unsigned)WS_MERGED, (unsigned)WS_WO_T, 2048u, 2048u, 64, 4, 16, F.G, (int)blockIdx.x};
        EpiResid E{xin, args.out, (bf16_t*)(F.ws + WS_XB), (float*)(F.ws + WS_PART)};
        g8::gemm_phase(F.lds, S, E);
        SEAM();
    }
    if (IN(PH_P5)) {
        SchedGrid S{F.ws, (unsigned)WS_XB, (unsigned)WS_WQ_T, 2048u, 2048u, 64, 4, 16, F.G, (int)blockIdx.x};
        EpiQ E{(const float*)(F.ws + WS_PART), (bf16_t*)(F.ws + WS_Q)};
        g8::gemm_phase(F.lds, S, E);
        SEAM();
    }
    if (IN(PH_P6)) { phase_attn(F, l); SEAM(); }
    if (IN(PH_P7)) {
        SchedGrid S{F.ws, (unsigned)WS_O, (unsigned)WS_WXO_T, 2048u, 2048u, 64, 4, 16, F.G, (int)blockIdx.x};
        EpiResid E{args.out, args.out, (bf16_t*)(F.ws + WS_XB), nullptr};
        g8::gemm_phase(F.lds, S, E);
        SEAM();
    }
    if (IN(PH_P8)) { phase_router(F, l, args.out); SEAM(); }
    if (IN(PH_P9)) {
        moe_table(F, l);
        SchedMoe1 S{F.ws, (unsigned)WS_XB, (unsigned)WS_WGU_T, (const int*)(F.ws + WS_ROWTOK), F.MISC, 2048u, 2048u, F.G, (int)blockIdx.x};
        EpiMoe1 E{(const float*)(F.ws + WS_ROWW), (const float*)(F.ws + WS_ROWRSTD), (bf16_t*)(F.ws + WS_ACT)};
        g8::gemm_phase_t<true>(F.lds, S, E);
        SEAM();
    }
    if (IN(PH_P10)) {
        moe_table(F, l);
        SchedMoe2 S{F.ws, (unsigned)WS_ACT, (unsigned)WS_WD_T, F.MISC, 512u, 512u, F.G, (int)blockIdx.x};
        EpiY E{(bf16_t*)(F.ws + WS_Y)};
        g8::gemm_phase(F.lds, S, E);
        SEAM();
    }
    if (IN(PH_P11)) {
        moe_table(F, l); phase_combine(F, args.out, l == 1);
        if (fused && l == 0) { phase_prep(F, 1, nullptr, false, 0); SEAM(); }
    }
    }
#undef IN
#undef SEAM
}
}

__global__ __launch_bounds__(256) void k_f32_to_bf16(const float* src, unsigned short* dst, size_t n4) {
    const size_t i = (size_t)blockIdx.x * 256 + threadIdx.x; if (i >= n4) return;
    const float4 v = ((const float4*)src)[i];
    uint2 o; o.x = mk::pk2(v.x, v.y); o.y = mk::pk2(v.z, v.w); ((uint2*)dst)[i] = o;
}

static int g_grid = 0;
static void mega_launch(hipStream_t stream, void* const* d_in, void* d_out, void* d_ws, int layer, int ph_lo, int ph_hi, int flags) {
    mk::Args a{};
    for (int i = 0; i < 28; ++i) a.in[i] = (const float*)d_in[i];
    a.out = (float*)d_out; a.ws = (unsigned char*)d_ws; a.ph_lo = ph_lo; a.ph_hi = ph_hi; a.layer = layer; a.flags = flags;
    hipLaunchKernelGGL(mk::mega, dim3(g_grid), dim3(mk::NTHREADS), mk::LDS_BYTES, stream, a);
}

extern "C" void kernel_launch(void* const* d_in, const int* in_sizes, int n_in, void* d_out, int out_size, void* d_ws, size_t ws_size, hipStream_t stream) {
    if (g_grid == 0) {
        int dev = 0, cus = 0, per_cu = 0;
        if (n_in != 28 || ws_size < mk::WS_END) { fprintf(stderr, "kernel_launch: unexpected n_in %d / ws_size %zu\n", n_in, ws_size); g_grid = -1; return; }
        (void)hipGetDevice(&dev); (void)hipDeviceGetAttribute(&cus, hipDeviceAttributeMultiprocessorCount, dev);
        if (hipFuncSetAttribute((const void*)mk::mega, hipFuncAttributeMaxDynamicSharedMemorySize, mk::LDS_BYTES) != hipSuccess) { fprintf(stderr, "hipFuncSetAttribute failed\n"); g_grid = -1; return; }
        if (hipOccupancyMaxActiveBlocksPerMultiprocessor(&per_cu, (const void*)mk::mega, mk::NTHREADS, mk::LDS_BYTES) != hipSuccess || per_cu < 1) { fprintf(stderr, "occupancy query: %d\n", per_cu); }
        (void)hipGetLastError();
        g_grid = cus > 0 ? cus : 256;
    }
    if (g_grid < 0) return;
    const float* x = (const float*)d_in[0];       const float* mem = (const float*)d_in[1];
    const float* norm_mix_g = (const float*)d_in[2]; const float* w_in = (const float*)d_in[3];
    const float* conv_a_w = (const float*)d_in[4]; const float* conv_a_b = (const float*)d_in[5];
    const float* ln_a_g = (const float*)d_in[6];   const float* ln_a_b = (const float*)d_in[7];
    const float* w_a_out = (const float*)d_in[8];  const float* w_pool_grp = (const float*)d_in[9];
    const float* pool_scale = (const float*)d_in[10]; const float* conv_c_w = (const float*)d_in[11];
    const float* w_c_out = (const float*)d_in[12];
    const float* norm_x_g = (const float*)d_in[14]; const float* norm_mem_g = (const float*)d_in[15];
    const float* w_xq = (const float*)d_in[16];    const float* w_xkv = (const float*)d_in[17];
    const float* w_xo = (const float*)d_in[18];    const float* norm_ffn_g = (const float*)d_in[19];
    const float* w_rg = (const float*)d_in[20];    const float* b_rg = (const float*)d_in[21];
    const float* w_re = (const float*)d_in[22];    const float* b_re = (const float*)d_in[23];
    const float* w_e_gate = (const float*)d_in[24]; const float* w_e_up = (const float*)d_in[25];
    const float* w_e_down = (const float*)d_in[26]; const float* norm_f_g = (const float*)d_in[27];
    float* X = (float*)d_out;
    const size_t MB = 1u << 20;
    char* ws = (char*)d_ws;
    float* B0 = (float*)(ws); float* B1 = (float*)(ws + 64 * MB); float* B2 = (float*)(ws + 128 * MB);
    float* MEMN = (float*)(ws + 192 * MB); float* KV = (float*)(ws + 200 * MB); float* GATE = (float*)(ws + 216 * MB);
    (void)hipMemsetAsync(ws + mk::WS_CTL, 0, mk::CTL_BYTES, stream);
    mega_launch(stream, d_in, d_out, d_ws, 0, 0, mk::PH_COUNT, 1 | 8);
}
```

```cpp
#include <hip/hip_runtime.h>
#include <cstdio>
#include <cstdint>

namespace mk {
#define LAS __attribute__((address_space(3)))
typedef unsigned short bf16_t;
typedef short bf16x8 __attribute__((ext_vector_type(8)));
typedef float f32x4 __attribute__((ext_vector_type(4)));
typedef float f32x2 __attribute__((ext_vector_type(2)));
typedef float f32x16 __attribute__((ext_vector_type(16)));
typedef unsigned u32x4 __attribute__((ext_vector_type(4)));
typedef unsigned u32x2 __attribute__((ext_vector_type(2)));
typedef __bf16 bf16x2_t __attribute__((ext_vector_type(2)));

constexpr int NTHREADS = 512, NWAVES = 8;
constexpr int RING_BYTES = 131072, CTRL_OFF = 135168  , MISC_OFF = CTRL_OFF + 320, LDS_BYTES = CTRL_OFF + 12288;
constexpr int NTOK = 16384, DM = 1024, SEQ = 2048;
constexpr float EPS = 1e-6f;

__device__ __forceinline__ unsigned pk2(float lo, float hi) { f32x2 v = {lo, hi}; bf16x2_t b = __builtin_convertvector(v, bf16x2_t); return __builtin_bit_cast(unsigned, b); }
__device__ __forceinline__ float bf_lo(unsigned w) { return __uint_as_float(w << 16); }
__device__ __forceinline__ float bf_hi(unsigned w) { return __uint_as_float(w & 0xffff0000u); }
__device__ __forceinline__ float sigm(float v) { return __builtin_amdgcn_rcpf(1.f + __builtin_amdgcn_exp2f(-1.4426950408889634f * v)); }

#define XB_TMO      128
#define XB_XCNT(j)  (256  + 64 * (j))
#define XB_XSUB(j)  (1280 + 64 * (j))
#define XB_XGEN(j)  (2304 + 64 * (j))
#define XB_TOP      3328
#define XB_TOPGEN   3392
#define XCD_BAR_WORDS 3456
#define XB_SPIN_CAP (1u << 18)
__device__ __forceinline__ unsigned xb_ld(unsigned* p)              { return __hip_atomic_load(p, __ATOMIC_RELAXED, __HIP_MEMORY_SCOPE_AGENT); }
__device__ __forceinline__ unsigned xb_add(unsigned* p, unsigned v) { return __hip_atomic_fetch_add(p, v, __ATOMIC_RELAXED, __HIP_MEMORY_SCOPE_AGENT); }
__device__ __forceinline__ unsigned xb_xcc_id() { return (unsigned)__builtin_amdgcn_s_getreg((3 << 11) | 20) & 0xFu; }
#define XB_SPIN(cond, bar) do { unsigned _sp = 0; while (cond) { __builtin_amdgcn_s_sleep(1); \
    if ((++_sp & 255u) == 0u) { if (xb_ld(&(bar)[XB_TMO])) break; if (_sp > XB_SPIN_CAP) { atomicAdd(&(bar)[XB_TMO], 1u); break; } } } } while (0)
struct XcdBarrier { unsigned* bar; unsigned x; volatile LAS unsigned* st; };
__device__ __forceinline__ XcdBarrier xcd_barrier_post(unsigned* bar, volatile LAS unsigned* st) {
    XcdBarrier b; b.bar = bar; b.x = xb_xcc_id(); b.st = st;
    if (threadIdx.x == 0) (void)xb_add(&bar[XB_XCNT(b.x)], 1u);
    return b;
}
__device__ __forceinline__ void xcd_barrier_complete(unsigned* bar, unsigned x, unsigned& nloc, unsigned& nx) {
    const unsigned G = gridDim.x * gridDim.y * gridDim.z;
    unsigned sum, cnt, mine, sp = 0u;
    for (;;) {
        sum = 0u; cnt = 0u; mine = 0u;
#pragma unroll
        for (unsigned j = 0; j < 16; ++j) { const unsigned c = xb_ld(&bar[XB_XCNT(j)]); sum += c; cnt += (c > 0u) ? 1u : 0u; mine = (j == x) ? c : mine; }
        if (sum == G) break;
        __builtin_amdgcn_s_sleep(1);
        if ((++sp & 255u) == 0u) { if (xb_ld(&bar[XB_TMO])) break; if (sp > XB_SPIN_CAP) { atomicAdd(&bar[XB_TMO], 1u); break; } }
    }
    nloc = mine > 0u ? mine : 1u; nx = cnt > 0u ? cnt : 1u;
}
__device__ __forceinline__ void xcd_barrier(const XcdBarrier& b) {
    asm volatile("s_waitcnt vmcnt(0)" ::: "memory");
    __syncthreads();
    if (threadIdx.x == 0) {
        unsigned* bar = b.bar;
        __builtin_amdgcn_s_waitcnt(0);
        unsigned nloc = b.st[0], nx = b.st[1];
        if (nloc == 0u) { xcd_barrier_complete(bar, b.x, nloc, nx); b.st[0] = nloc; b.st[1] = nx; }
        const unsigned old = xb_add(&bar[XB_XSUB(b.x)], 1u);
        const unsigned gen = old / nloc;
        if (old + 1u == (gen + 1u) * nloc) {
            __builtin_amdgcn_fence(__ATOMIC_RELEASE, "agent");
            asm volatile("s_waitcnt vmcnt(0)" ::: "memory");
            const unsigned og = xb_add(&bar[XB_TOP], 1u);
            const unsigned tg = og / nx;
            if (og + 1u == (tg + 1u) * nx) xb_add(&bar[XB_TOPGEN], 1u);
            else XB_SPIN(xb_ld(&bar[XB_TOPGEN]) == tg, bar);
            __builtin_amdgcn_fence(__ATOMIC_ACQUIRE, "agent");
            xb_add(&bar[XB_XGEN(b.x)], 1u);
            asm volatile("s_waitcnt vmcnt(0)" ::: "memory");
        } else {
            XB_SPIN(xb_ld(&bar[XB_XGEN(b.x)]) == gen, bar);
            __builtin_amdgcn_fence(__ATOMIC_ACQUIRE, "agent");
            asm volatile("s_waitcnt vmcnt(0)" ::: "memory");
        }
    }
    __syncthreads();
}

namespace g8 {
constexpr int BM = 256, BK = 64, HALF = 128, HTB = HALF * BK * 2, STAGE_BYTES = 8 * HTB, NXCD = 8, WGM = 8;
__device__ __forceinline__ int lds_byte(int r, int c) { const int st = (r >> 4) * 2 + (c >> 5), rr = r & 15, cc = c & 31, ob = rr * 64 + cc * 2; return st * 1024 + (ob ^ (((ob >> 9) & 1) << 5)); }
__device__ __forceinline__ void stage_rc(int b, int& R, int& C) { const int st = b / 1024, sb = b % 1024, swz = sb ^ (((sb >> 9) & 1) << 5); R = (st >> 1) * 16 + swz / 64; C = (st & 1) * 32 + (swz % 64) / 2; }

struct Unit { unsigned A, B; const int* gth; int nt, pm, pn, kind, nvalid; };

__device__ __forceinline__ bool static_tile(int nM, int nN, int G, int c, int i, int& pm, int& pn) {
    const int nwg = nM * nN; const long L = (long)i * G + c; if (L >= nwg) return false;
    int wgid = (int)L; { const int q = nwg / NXCD, r = nwg % NXCD, xcd = wgid % NXCD, off = wgid / NXCD; wgid = (xcd < r ? xcd * (q + 1) : r * (q + 1) + (xcd - r) * q) + off; }
    const int nig = WGM * nN, gid = wgid / nig, fm = gid * WGM, gsz = (nM - fm) < WGM ? (nM - fm) : WGM;
    pm = fm + ((wgid % nig) % gsz); pn = (wgid % nig) / gsz; return true;
}

template <bool GATHER, class Epi, class Sched>
__device__ __forceinline__ void gemm_phase_t(LAS unsigned char* lds, const Sched& S, const Epi& E) {
    int tid_ = threadIdx.x; asm volatile("" : "+v"(tid_));
    const int tid = tid_, wid = __builtin_amdgcn_readfirstlane(tid >> 6), lane = tid & 63, wr = wid >> 2, wc = wid & 3, fr = lane & 15, fq = lane >> 4;
    const unsigned lda = S.lda, ldb = S.ldb;
    unsigned voffA[2], voffB[2], voffA1[2];
#pragma unroll
    for (int i = 0; i < 2; ++i) { int R, C; stage_rc(tid * 16 + i * 8192, R, C); voffA[i] = (unsigned)R * lda + (unsigned)C * 2u; voffB[i] = (unsigned)R * ldb + (unsigned)C * 2u; voffA1[i] = voffA[i]; }
    constexpr int GOFF_OFF = CTRL_OFF + 4096;
#define G8_GOFF(u, o0, o1) do { _Pragma("unroll") for (int _i = 0; _i < 2; ++_i) { int R_, C_; stage_rc(tid * 16 + _i * 8192, R_, C_); const int r0_ = R_, r1_ = 128 + R_; \
        const int t0_ = (r0_ < (u).nvalid) ? (u).gth[r0_] : 0, t1_ = (r1_ < (u).nvalid) ? (u).gth[r1_] : 0; \
        o0[_i] = (unsigned)t0_ * lda + (unsigned)C_ * 2u; o1[_i] = (unsigned)t1_ * lda + (unsigned)C_ * 2u; asm volatile("" : "+v"(o0[_i]), "+v"(o1[_i])); } } while (0)
    const unsigned kstep = (unsigned)(BK * 2);
    const unsigned hsA = GATHER ? 0u : (unsigned)HALF * lda, hsB = (unsigned)HALF * ldb;
    const __amdgpu_buffer_rsrc_t rsrc = __builtin_amdgcn_make_buffer_rsrc((void*)S.ws, 0, 0x7ffffff0, 0x00020000);
    const unsigned ldsw = (unsigned)wid * 1024u;
    const int aoff = lds_byte(wr * 64 + fr, fq * 8), boff = lds_byte(wc * 32 + fr, fq * 8);
#define G8_SA(b, h) (((b) * 2 + (h)) * HTB)
#define G8_SB(b, h) ((4 + (b) * 2 + (h)) * HTB)
#define G8_STAGE(bufoff, gbase, voff) do { _Pragma("unroll") for (int _i = 0; _i < 2; ++_i) \
        __builtin_amdgcn_raw_ptr_buffer_load_lds(rsrc, (LAS void*)(lds + (bufoff) + ldsw + _i * 8192), 16, (int)(voff)[_i], (int)(gbase), 0, 0); } while (0)
#define G8_LDA(dst, b, h) do { _Pragma("unroll") for (int m = 0; m < 4; ++m) _Pragma("unroll") for (int k = 0; k < 2; ++k) dst[m][k] = *(const LAS bf16x8*)(lds + G8_SA(b, h) + aoff + m * 2048 + k * 1024); } while (0)
#define G8_LDB(dst, b, h) do { _Pragma("unroll") for (int n = 0; n < 2; ++n) _Pragma("unroll") for (int k = 0; k < 2; ++k) dst[n][k] = *(const LAS bf16x8*)(lds + G8_SB(b, h) + boff + n * 2048 + k * 1024); } while (0)
#define G8_MMA(ai, bj, At, Bt) do { __builtin_amdgcn_s_setprio(1); _Pragma("unroll") for (int m = 0; m < 4; ++m) _Pragma("unroll") for (int n = 0; n < 2; ++n) _Pragma("unroll") for (int k = 0; k < 2; ++k) \
        acc[ai][bj][m][n] = __builtin_amdgcn_mfma_f32_16x16x32_bf16(Bt[n][k], At[m][k], acc[ai][bj][m][n], 0, 0, 0); __builtin_amdgcn_s_setprio(0); } while (0)
#define G8_WAIT_V(n) asm volatile("s_waitcnt vmcnt(" #n ")" ::: "memory")
#define G8_WAIT_L(n) asm volatile("s_waitcnt lgkmcnt(" #n ")" ::: "memory")
#define G8_BAR __builtin_amdgcn_s_barrier()
#define G8_SCHED __builtin_amdgcn_sched_barrier(0)
    Unit cur, nxt; int ui = 0;
    if (!S.next(0, cur)) return;
    f32x4 acc[2][2][4][2];
#pragma unroll
    for (int a = 0; a < 2; ++a)
#pragma unroll
        for (int b = 0; b < 2; ++b)
#pragma unroll
            for (int m = 0; m < 4; ++m)
#pragma unroll
                for (int n = 0; n < 2; ++n) acc[a][b][m][n] = (f32x4){0.f, 0.f, 0.f, 0.f};
    bf16x8 At[4][2], B0[2][2], B1[2][2];
    unsigned cA = cur.A, cB = cur.B;
    if constexpr (GATHER) G8_GOFF(cur, voffA, voffA1);
    G8_STAGE(G8_SB(0, 0), cB, voffB); G8_STAGE(G8_SB(0, 1), cB + hsB, voffB); G8_STAGE(G8_SA(0, 0), cA, voffA); G8_STAGE(G8_SA(0, 1), cA + hsA, voffA1);
    if (wr == 1) G8_BAR;
    G8_WAIT_V(2); G8_BAR;
    G8_STAGE(G8_SB(1, 0), cB + kstep, voffB); G8_STAGE(G8_SA(1, 0), cA + kstep, voffA); G8_STAGE(G8_SB(1, 1), cB + hsB + kstep, voffB);
    G8_WAIT_V(6); G8_BAR;
    for (;;) {
        const bool has_next = S.next(ui + 1, nxt);
        const unsigned nA = has_next ? nxt.A : cA, nB = has_next ? nxt.B : cB;
        if constexpr (GATHER) { unsigned go0[2], go1[2]; if (has_next) G8_GOFF(nxt, go0, go1); else { go0[0] = voffA[0]; go0[1] = voffA[1]; go1[0] = voffA1[0]; go1[1] = voffA1[1]; }
            *(LAS u32x4*)(lds + GOFF_OFF + tid * 16) = (u32x4){go0[0], go0[1], go1[0], go1[1]}; }
        const int nt = cur.nt;
#pragma unroll 1
        for (int t = 0; t < nt; t += 2) {
            const bool last = (t == nt - 2);
            const unsigned a1 = cA + (unsigned)(t + 1) * kstep;
            const unsigned a2 = last ? nA : cA + (unsigned)(t + 2) * kstep, b2 = last ? nB : cB + (unsigned)(t + 2) * kstep;
            const unsigned a3 = a2 + kstep, b3 = b2 + kstep;
            unsigned o2h0[2], o2h1[2];
            if constexpr (GATHER) { o2h0[0] = voffA[0]; o2h0[1] = voffA[1]; o2h1[0] = voffA1[0]; o2h1[1] = voffA1[1];
                if (last) { const u32x4 nv_ = *(const LAS u32x4*)(lds + GOFF_OFF + tid * 16); o2h0[0] = nv_.x; o2h0[1] = nv_.y; o2h1[0] = nv_.z; o2h1[1] = nv_.w; } }
            else { o2h0[0] = voffA[0]; o2h0[1] = voffA[1]; o2h1[0] = voffA[0]; o2h1[1] = voffA[1]; }
            G8_LDB(B0, 0, 0); G8_LDB(B1, 0, 1); G8_SCHED; G8_LDA(At, 0, 0); G8_STAGE(G8_SA(1, 1), a1 + hsA, voffA1);
            G8_WAIT_V(8); G8_WAIT_L(0); G8_BAR; G8_MMA(0, 0, At, B0); G8_MMA(0, 1, At, B1); G8_BAR; G8_SCHED;
            G8_LDA(At, 0, 1); G8_STAGE(G8_SB(0, 0), b2, voffB); G8_STAGE(G8_SB(0, 1), b2 + hsB, voffB); G8_STAGE(G8_SA(0, 0), a2, o2h0);
            G8_WAIT_V(8); G8_WAIT_L(0); G8_BAR; G8_MMA(1, 0, At, B0); G8_MMA(1, 1, At, B1); G8_BAR; G8_SCHED;
            G8_LDB(B0, 1, 0); G8_LDB(B1, 1, 1); G8_SCHED; G8_LDA(At, 1, 0); G8_STAGE(G8_SA(0, 1), a2 + hsA, o2h1);
            G8_WAIT_V(8); G8_WAIT_L(0); G8_BAR; G8_MMA(0, 0, At, B0); G8_MMA(0, 1, At, B1); G8_BAR; G8_SCHED;
            G8_LDA(At, 1, 1); G8_STAGE(G8_SB(1, 0), b3, voffB); G8_STAGE(G8_SB(1, 1), b3 + hsB, voffB); G8_STAGE(G8_SA(1, 0), a3, o2h0);
            G8_WAIT_V(8); G8_WAIT_L(0); G8_BAR; G8_MMA(1, 0, At, B0); G8_MMA(1, 1, At, B1); G8_BAR; G8_SCHED;
        }
        if (wr == 0) G8_BAR;
        { int fr_ = fr, fq_ = fq; asm volatile("" : "+v"(fr_), "+v"(fq_)); E(acc, cur, wr, wc, fr_, fq_); }
        if (!has_next) break;
#pragma unroll
        for (int a = 0; a < 2; ++a)
#pragma unroll
            for (int b = 0; b < 2; ++b)
#pragma unroll
                for (int m = 0; m < 4; ++m)
#pragma unroll
                    for (int n = 0; n < 2; ++n) acc[a][b][m][n] = (f32x4){0.f, 0.f, 0.f, 0.f};
        cur = nxt; cA = nA; cB = nB; ++ui;
        if constexpr (GATHER) { const u32x4 nv_ = *(const LAS u32x4*)(lds + GOFF_OFF + tid * 16); voffA[0] = nv_.x; voffA[1] = nv_.y; voffA1[0] = nv_.z; voffA1[1] = nv_.w; }
        if (wr == 1) G8_BAR;
    }
    G8_WAIT_V(0);
    G8_BAR;
#undef G8_GOFF
#undef G8_SA
#undef G8_SB
#undef G8_STAGE
#undef G8_LDA
#undef G8_LDB
#undef G8_MMA
#undef G8_WAIT_V
#undef G8_WAIT_L
#undef G8_BAR
#undef G8_SCHED
}
template <class Epi, class Sched> __device__ __forceinline__ void gemm_phase(LAS unsigned char* lds, const Sched& S, const Epi& E) { gemm_phase_t<false, Epi, Sched>(lds, S, E); }
}

constexpr size_t MiB = 1u << 20;
constexpr size_t WS_RSTD_MIX = 1 * MiB, WS_RSTD_FFN = 1 * MiB + 65536, WS_TOKSLOT = 1 * MiB + 131072;
constexpr size_t WS_PART = 2 * MiB, WS_ROWTOK = 3 * MiB, WS_ROWW = 4 * MiB, WS_ROWRSTD = 5 * MiB, WS_WR = 6 * MiB;
constexpr size_t WS_WIN_T = 8 * MiB, WS_WA_T = 20 * MiB, WS_WP_T = 21 * MiB, WS_WC_T = 22 * MiB, WS_WO_T = 23 * MiB, WS_WQ_T = 25 * MiB, WS_WXO_T = 27 * MiB;
constexpr size_t WS_WGU_T = 29 * MiB, WS_WD_T = 45 * MiB;
constexpr size_t WS_KV = 53 * MiB;
constexpr size_t WS_XB = 69 * MiB, WS_AACT = 69 * MiB, WS_PIN = 85 * MiB;
constexpr size_t WS_ABUF = 101 * MiB, WS_UBUF = 117 * MiB, WS_CXC = 133 * MiB, WS_CB = 149 * MiB, WS_MERGED = 101 * MiB, WS_ACT = 101 * MiB;
constexpr size_t WS_G = 165 * MiB, WS_WKV_T = 165 * MiB, WS_MEMB = 181 * MiB, WS_Q = 165 * MiB, WS_O = 197 * MiB, WS_Y = 165 * MiB;
constexpr size_t WS_CTL = 262 * MiB, CTL_BYTES = 1 * MiB, WS_END = 263 * MiB;
constexpr int CW_BAR = 4096;
constexpr int CW_ECNT = 8192;

struct Args {
    const float* in[28];
    float* out; unsigned char* ws;
    int ph_lo, ph_hi, layer, flags;
};
struct Frame {
    LAS unsigned char* lds; volatile LAS unsigned* MISC; unsigned* ctl;
    int tid, lane, wave, vcu, G;
    unsigned char* ws;
};
constexpr int PTAB_OFF = CTRL_OFF + 2048;
__device__ __forceinline__ const float* inptr(const Frame& F, int i) {
    const unsigned long long v = ((const LAS unsigned long long*)(F.lds + PTAB_OFF))[i];
    const unsigned lo = __builtin_amdgcn_readfirstlane((unsigned)v), hi = __builtin_amdgcn_readfirstlane((unsigned)(v >> 32));
    return (const float*)(((unsigned long long)hi << 32) | lo);
}
__device__ __forceinline__ float wave_sum(float v) {
#pragma unroll
    for (int o = 1; o < 64; o <<= 1) v += __shfl_xor(v, o);
    return v;
}

__device__ __forceinline__ int p8_logical(int p) { return (p & ~31) | (((p >> 2) & 3) << 3) | (((p >> 4) & 1) << 2) | (p & 3); }
struct ColRef { const float* p; int ld; float scale; };
template <class MapF>
__device__ __forceinline__ void prep_item(const MapF& cref, const float* gain, bf16_t* WT, int ldw, int k0, int p0, LAS float* scr, int lane) {
    const ColRef cr = cref(p0 + (lane & 31));
    const float* p = cr.p + (size_t)(k0 + (lane >> 5)) * cr.ld; const size_t step = (size_t)2 * cr.ld;
    float v[32];
#pragma unroll
    for (int i = 0; i < 32; ++i) { v[i] = *p; p += step; }
    const int c = lane & 7;
    f32x4 g0 = (f32x4){1.f, 1.f, 1.f, 1.f}, g1 = g0;
    if (gain) { g0 = *(const f32x4*)(gain + k0 + 8 * c); g1 = *(const f32x4*)(gain + k0 + 8 * c + 4); }
#pragma unroll
    for (int i = 0; i < 32; ++i) scr[(2 * i + (lane >> 5)) * 33 + (lane & 31)] = v[i] * cr.scale;
    asm volatile("s_waitcnt lgkmcnt(0)" ::: "memory");
#pragma unroll
    for (int j = 0; j < 4; ++j) { const int n = (lane >> 3) + 8 * j; const LAS float* s = scr + (8 * c) * 33 + n;
        u32x4 o; o.x = pk2(s[0 * 33] * g0[0], s[1 * 33] * g0[1]); o.y = pk2(s[2 * 33] * g0[2], s[3 * 33] * g0[3]); o.z = pk2(s[4 * 33] * g1[0], s[5 * 33] * g1[1]); o.w = pk2(s[6 * 33] * g1[2], s[7 * 33] * g1[3]);
        *(u32x4*)(WT + (size_t)(p0 + n) * ldw + k0 + 8 * c) = o; }
    asm volatile("s_waitcnt lgkmcnt(0)" ::: "memory");
}
struct MapPlain { const float* W; int ld; int off; __device__ ColRef operator()(int p) const { return ColRef{W + off + p8_logical(p), ld, 1.f}; } };
struct MapNatural { const float* W; int ld; int off; __device__ ColRef operator()(int p) const { return ColRef{W + off + p, ld, 1.f}; } };
struct MapWin { const float* W; __device__ ColRef operator()(int p) const {
    const int L = p8_logical(p), tile = L >> 8, q8 = (L & 255) >> 3, w = L & 7; int col;
    if (tile < 4) col = (w < 4 ? 0 : 512) + 128 * tile + 4 * q8 + (w & 3);
    else if (tile < 6) col = L;
    else if (tile < 10) col = (w < 4 ? 1536 : 2560) + 128 * (tile - 6) + 4 * q8 + (w & 3);
    else if (tile < 12) col = L - 512;
    else col = L;
    return ColRef{W + col, 6144, 1.f}; } };
struct MapPool { const float* W; const float* ps; __device__ ColRef operator()(int p) const {
    const int n = p8_logical(p); return ColRef{W + (size_t)(n >> 8) * 128 * 256 + (n & 255), 256, ps[n]}; } };
struct MapGU { const float* Wg; long du; __device__ ColRef operator()(int p) const {
    const int L = p8_logical(p), tile = L >> 8, q8 = (L & 255) >> 3, w = L & 7; const int ch = 128 * tile + 4 * q8 + (w & 3);
    return ColRef{Wg + (w < 4 ? 0l : du) + ch, 256, 1.f}; } };

enum { I_X = 0, I_MEM, I_NORM_MIX_G, I_W_IN, I_CONV_A_W, I_CONV_A_B, I_LN_A_G, I_LN_A_B, I_W_A_OUT, I_W_POOL, I_POOL_SCALE, I_CONV_C_W, I_W_C_OUT, I_W_O,
       I_NORM_X_G, I_NORM_MEM_G, I_W_XQ, I_W_XKV, I_W_XO, I_NORM_FFN_G, I_W_RG, I_B_RG, I_W_RE, I_B_RE, I_W_E_GATE, I_W_E_UP, I_W_E_DOWN, I_NORM_F_G };

__device__ __forceinline__ void row2_rstd_bf16(const float* xrow, bf16_t* orow, float* rstd_out, bool normalise, int lane) {
    const f32x4* xr = (const f32x4*)xrow + lane;
    f32x4 v[8]; float s0 = 0.f, s1 = 0.f;
#pragma unroll
    for (int j = 0; j < 8; ++j) v[j] = xr[64 * j];
#pragma unroll
    for (int j = 0; j < 4; ++j) { s0 += (v[j].x * v[j].x + v[j].y * v[j].y) + (v[j].z * v[j].z + v[j].w * v[j].w); s1 += (v[j + 4].x * v[j + 4].x + v[j + 4].y * v[j + 4].y) + (v[j + 4].z * v[j + 4].z + v[j + 4].w * v[j + 4].w); }
    const float r0 = rsqrtf(wave_sum(s0) * (1.f / DM) + EPS), r1 = rsqrtf(wave_sum(s1) * (1.f / DM) + EPS);
    if (rstd_out && lane == 0) { rstd_out[0] = r0; rstd_out[1] = r1; }
    u32x2* o8 = (u32x2*)orow + lane;
#pragma unroll
    for (int j = 0; j < 8; ++j) { const float sc = normalise ? (j < 4 ? r0 : r1) : 1.f; u32x2 w; w.x = pk2(v[j].x * sc, v[j].y * sc); w.y = pk2(v[j].z * sc, v[j].w * sc); o8[64 * j] = w; }
}

__device__ __forceinline__ void phase_prep(Frame& F, int l, const float* xsrc, bool do_mem, int kvmask) {
    LAS float* scr = (LAS float*)(F.lds + F.wave * 16384);
    const int gw = F.vcu * NWAVES + F.wave, NGW = F.G * NWAVES, lane = F.lane;
    unsigned char* ws = F.ws;
    const float* g_mix = inptr(F, I_NORM_MIX_G) + l * DM; const float* g_x = inptr(F, I_NORM_X_G) + l * DM; const float* g_ffn = inptr(F, I_NORM_FFN_G) + l * DM;
    constexpr int N_WIN = 16 * 192, N_WA = 8 * 32, N_WP = 2 * 32, N_WC = 8 * 32, N_SQ = 16 * 32, N_GU = 16 * 16, N_D = 4 * 32;
    constexpr int N_FIXED = N_WIN + N_WA + N_WP + N_WC + 3 * N_SQ + 16 * N_GU + 16 * N_D;
    const int n_kv = 2 * N_SQ;
    const int total = N_FIXED + ((kvmask & 1) ? n_kv : 0) + ((kvmask & 2) ? n_kv : 0);
    for (int it = gw; it < total; it += NGW) {
        int r = it;
        if (r < N_WIN) { MapWin mp{inptr(F, I_W_IN) + (size_t)l * DM * 6144}; prep_item(mp, g_mix, (bf16_t*)(ws + WS_WIN_T), 1024, 64 * (r / 192), 32 * (r % 192), scr, lane); continue; } r -= N_WIN;
        if (r < N_WA) { MapPlain mp{inptr(F, I_W_A_OUT) + (size_t)l * 512 * DM, DM, 0}; prep_item(mp, nullptr, (bf16_t*)(ws + WS_WA_T), 512, 64 * (r / 32), 32 * (r % 32), scr, lane); continue; } r -= N_WA;
        if (r < N_WP) { MapPool mp{inptr(F, I_W_POOL) + (size_t)l * 4 * 128 * 256, inptr(F, I_POOL_SCALE) + l * DM}; prep_item(mp, nullptr, (bf16_t*)(ws + WS_WP_T), 512, 64 * (r / 32), 32 * (r % 32), scr, lane); continue; } r -= N_WP;
        if (r < N_WC) { MapPlain mp{inptr(F, I_W_C_OUT) + (size_t)l * 512 * DM, DM, 0}; prep_item(mp, nullptr, (bf16_t*)(ws + WS_WC_T), 512, 64 * (r / 32), 32 * (r % 32), scr, lane); continue; } r -= N_WC;
        if (r < N_SQ) { MapPlain mp{inptr(F, I_W_O) + (size_t)l * DM * DM, DM, 0}; prep_item(mp, nullptr, (bf16_t*)(ws + WS_WO_T), 1024, 64 * (r / 32), 32 * (r % 32), scr, lane); continue; } r -= N_SQ;
        if (r < N_SQ) { MapPlain mp{inptr(F, I_W_XQ) + (size_t)l * DM * DM, DM, 0}; prep_item(mp, g_x, (bf16_t*)(ws + WS_WQ_T), 1024, 64 * (r / 32), 32 * (r % 32), scr, lane); continue; } r -= N_SQ;
        if (r < N_SQ) { MapPlain mp{inptr(F, I_W_XO) + (size_t)l * DM * DM, DM, 0}; prep_item(mp, nullptr, (bf16_t*)(ws + WS_WXO_T), 1024, 64 * (r / 32), 32 * (r % 32), scr, lane); continue; } r -= N_SQ;
        if (r < 16 * N_GU) { const int e = r / N_GU, q = r % N_GU; const size_t eo = ((size_t)l * 16 + e) * DM * 256;
            const float* wg_ = inptr(F, I_W_E_GATE); MapGU mp{wg_ + eo, (long)(inptr(F, I_W_E_UP) - wg_)}; prep_item(mp, g_ffn, (bf16_t*)(ws + WS_WGU_T) + (size_t)e * 512 * 1024, 1024, 64 * (q / 16), 32 * (q % 16), scr, lane); continue; } r -= 16 * N_GU;
        if (r < 16 * N_D) { const int e = r / N_D, q = r % N_D; const size_t eo = ((size_t)l * 16 + e) * 256 * DM;
            MapPlain mp{inptr(F, I_W_E_DOWN) + eo, DM, 0}; prep_item(mp, nullptr, (bf16_t*)(ws + WS_WD_T) + (size_t)e * 1024 * 256, 256, 64 * (q / 32), 32 * (q % 32), scr, lane); continue; } r -= 16 * N_D;
        int kl = 0; if ((kvmask & 1) && r >= n_kv) { r -= n_kv; kl = 1; } else if (!(kvmask & 1)) kl = 1;
        const float* wkv = inptr(F, I_W_XKV) + (size_t)kl * DM * 2048; const float* g_mem = inptr(F, I_NORM_MEM_G) + kl * DM;
        bf16_t* dst = (bf16_t*)(ws + WS_WKV_T) + (size_t)kl * 2 * DM * DM;
        if (r < N_SQ) { MapPlain mp{wkv, 2048, 0}; prep_item(mp, g_mem, dst, 1024, 64 * (r / 32), 32 * (r % 32), scr, lane); }
        else { r -= N_SQ; MapNatural mp{wkv, 2048, 1024}; prep_item(mp, g_mem, dst + (size_t)DM * DM, 1024, 64 * (r / 32), 32 * (r % 32), scr, lane); }
    }
    for (int i = gw * 64 + lane; i < 20 * DM; i += NGW * 64) { const int j = i / DM, k = i % DM;
        const float w = (j < 4) ? inptr(F, I_W_RG)[(size_t)l * DM * 4 + k * 4 + j] : inptr(F, I_W_RE)[(size_t)l * DM * 16 + k * 16 + (j - 4)];
        ((float*)(ws + WS_WR))[i] = w * g_ffn[k]; }
    if (xsrc) for (int m = 2 * gw; m < NTOK; m += 2 * NGW) row2_rstd_bf16(xsrc + (size_t)m * DM, (bf16_t*)(ws + WS_XB) + (size_t)m * DM, (float*)(ws + WS_RSTD_MIX) + m, false, lane);
    if (do_mem) for (int m = 2 * gw; m < 2048; m += 2 * NGW) row2_rstd_bf16(inptr(F, I_MEM) + (size_t)m * DM, (bf16_t*)(ws + WS_MEMB) + (size_t)m * DM, nullptr, true, lane);
}

struct SchedGrid {
    const unsigned char* ws; unsigned A, B; unsigned lda, ldb; int nM, nN, nt, G, c;
    __device__ __forceinline__ bool next(int i, g8::Unit& u) const {
        int pm, pn; if (!g8::static_tile(nM, nN, G, c, i, pm, pn)) return false;
        u.A = A + (unsigned)pm * 256u * lda; u.B = B + (unsigned)pn * 256u * ldb; u.nt = nt; u.pm = pm; u.pn = pn; u.kind = 0; return true;
    }
};

struct EpiResid {
    const float* Xin; float* X; bf16_t* XB; float* part;
    __device__ __forceinline__ void operator()(f32x4 (&acc)[2][2][4][2], const g8::Unit& u, int wr, int wc, int fr, int fq) const {
#pragma unroll
        for (int ai = 0; ai < 2; ++ai)
#pragma unroll
            for (int m = 0; m < 4; ++m) {
                const int row = u.pm * 256 + ai * 128 + wr * 64 + m * 16 + fr; float ss = 0.f;
#pragma unroll
                for (int bj = 0; bj < 2; ++bj) {
                    const size_t off = (size_t)row * DM + u.pn * 256 + bj * 128 + wc * 32 + 8 * fq;
                    const f32x4 x0 = *(const f32x4*)(Xin + off) + acc[ai][bj][m][0], x1 = *(const f32x4*)(Xin + off + 4) + acc[ai][bj][m][1];
                    *(f32x4*)(X + off) = x0; *(f32x4*)(X + off + 4) = x1;
                    if (XB) { u32x4 w; w.x = pk2(x0[0], x0[1]); w.y = pk2(x0[2], x0[3]); w.z = pk2(x1[0], x1[1]); w.w = pk2(x1[2], x1[3]); *(u32x4*)(XB + off) = w; }
                    ss += (x0[0] * x0[0] + x0[1] * x0[1]) + (x0[2] * x0[2] + x0[3] * x0[3]) + (x1[0] * x1[0] + x1[1] * x1[1]) + (x1[2] * x1[2] + x1[3] * x1[3]);
                }
                if (part) { ss += __shfl_xor(ss, 16); ss += __shfl_xor(ss, 32); if (fq == 0) part[(size_t)row * 16 + u.pn * 4 + wc] = ss; }
            }
    }
};


struct EpiInProj {
    const float* rstd; bf16_t *Abuf, *Ubuf, *CXC, *CB, *G;
    __device__ __forceinline__ void operator()(f32x4 (&acc)[2][2][4][2], const g8::Unit& u, int wr, int wc, int fr, int fq) const {
        const int pn = u.pn;
#pragma unroll
        for (int ai = 0; ai < 2; ++ai)
#pragma unroll
            for (int m = 0; m < 4; ++m) {
                const int row = u.pm * 256 + ai * 128 + wr * 64 + m * 16 + fr; const float s = rstd[row];
#pragma unroll
                for (int bj = 0; bj < 2; ++bj) {
                    const f32x4 v0 = acc[ai][bj][m][0] * s, v1 = acc[ai][bj][m][1] * s;
                    const int c8 = bj * 128 + wc * 32 + 8 * fq;
                    if (pn < 4 || (pn >= 6 && pn < 10)) {
                        f32x4 r;
                        if (pn < 4) { r[0] = v0[0] * sigm(v1[0]); r[1] = v0[1] * sigm(v1[1]); r[2] = v0[2] * sigm(v1[2]); r[3] = v0[3] * sigm(v1[3]); }
                        else r = v0 * v1;
                        bf16_t* dst = (pn < 4) ? Abuf + (size_t)row * 512 + 128 * pn + (c8 >> 1) : CXC + (size_t)row * 512 + 128 * (pn - 6) + (c8 >> 1);
                        u32x2 w; w.x = pk2(r[0], r[1]); w.y = pk2(r[2], r[3]); *(u32x2*)dst = w;
                    } else {
                        f32x4 a = v0, b = v1; bf16_t* dst;
                        if (pn < 6) dst = Ubuf + (size_t)row * 512 + 256 * (pn - 4) + c8;
                        else if (pn < 12) dst = CB + (size_t)row * 512 + 256 * (pn - 10) + c8;
                        else { dst = G + (size_t)row * 3072 + 256 * (pn - 12) + c8;
                            a[0] = sigm(a[0]); a[1] = sigm(a[1]); a[2] = sigm(a[2]); a[3] = sigm(a[3]); b[0] = sigm(b[0]); b[1] = sigm(b[1]); b[2] = sigm(b[2]); b[3] = sigm(b[3]); }
                        u32x4 w; w.x = pk2(a[0], a[1]); w.y = pk2(a[2], a[3]); w.z = pk2(b[0], b[1]); w.w = pk2(b[2], b[3]); *(u32x4*)dst = w;
                    }
                }
            }
    }
};

struct SchedMerge {
    const unsigned char* ws; unsigned Aact, Pin, Cact, Wa, Wp, Wc; unsigned lda, ldb; int G, c;
    __device__ __forceinline__ bool next(int i, g8::Unit& u) const {
        const int round = i / 3, kind = i - 3 * round; int pm, pn; if (!g8::static_tile(64, 4, G, c, round, pm, pn)) return false;
        const unsigned ao = (unsigned)pm * 256u * 1024u, bo = (unsigned)pn * 256u * 1024u;
        if (kind == 0) { u.A = Aact + ao; u.B = Wa + bo; u.nt = 8; }
        else if (kind == 1) { u.A = Pin + ao + (unsigned)pn * 256u; u.B = Wp + bo; u.nt = 2; }
        else { u.A = Cact + ao; u.B = Wc + bo; u.nt = 8; }
        u.pm = pm; u.pn = pn; u.kind = kind; return true;
    }
};
struct EpiMerge {
    const bf16_t* G; bf16_t* M;
    __device__ __forceinline__ void operator()(f32x4 (&acc)[2][2][4][2], const g8::Unit& u, int wr, int wc, int fr, int fq) const {
        const int kind = u.kind;
#pragma unroll
        for (int ai = 0; ai < 2; ++ai)
#pragma unroll
            for (int m = 0; m < 4; ++m) {
                const int row = u.pm * 256 + ai * 128 + wr * 64 + m * 16 + fr;
#pragma unroll
                for (int bj = 0; bj < 2; ++bj) {
                    const int col = u.pn * 256 + bj * 128 + wc * 32 + 8 * fq;
                    const u32x4 g = *(const u32x4*)(G + (size_t)row * 3072 + kind * 1024 + col);
                    f32x4 r0, r1;
                    r0[0] = bf_lo(g.x) * acc[ai][bj][m][0][0]; r0[1] = bf_hi(g.x) * acc[ai][bj][m][0][1]; r0[2] = bf_lo(g.y) * acc[ai][bj][m][0][2]; r0[3] = bf_hi(g.y) * acc[ai][bj][m][0][3];
                    r1[0] = bf_lo(g.z) * acc[ai][bj][m][1][0]; r1[1] = bf_hi(g.z) * acc[ai][bj][m][1][1]; r1[2] = bf_lo(g.w) * acc[ai][bj][m][1][2]; r1[3] = bf_hi(g.w) * acc[ai][bj][m][1][3];
                    bf16_t* mp = M + (size_t)row * 1024 + col;
                    if (kind != 0) { const u32x4 o = *(const u32x4*)mp;
                        r0[0] += bf_lo(o.x); r0[1] += bf_hi(o.x); r0[2] += bf_lo(o.y); r0[3] += bf_hi(o.y); r1[0] += bf_lo(o.z); r1[1] += bf_hi(o.z); r1[2] += bf_lo(o.w); r1[3] += bf_hi(o.w); }
                    u32x4 w; w.x = pk2(r0[0], r0[1]); w.y = pk2(r0[2], r0[3]); w.z = pk2(r1[0], r1[1]); w.w = pk2(r1[2], r1[3]); *(u32x4*)mp = w;
                }
            }
    }
};

#define OPQ(p) asm volatile("" : "+v"(p))
template <int W> __device__ __forceinline__ void pool_half(const bf16_t* U, bf16_t* P, int t0, int c) {
    float f0[31 + W], f1[31 + W];
    const bf16_t* up = U + (ptrdiff_t)(t0 - W + 1) * 512 + c;
#pragma unroll
    for (int i = 0; i < 31 + W; ++i) { const unsigned w = *(const unsigned*)up; up += 512; OPQ(up); const bool z = (t0 - W + 1 + i) < 0; f0[i] = z ? 0.f : bf_lo(w); f1[i] = z ? 0.f : bf_hi(w); }
    float s0 = 0.f, s1 = 0.f;
#pragma unroll
    for (int i = 0; i < W - 1; ++i) { s0 += f0[i]; s1 += f1[i]; }
    bf16_t* pp = P + (size_t)t0 * 512 + c;
#pragma unroll
    for (int tt = 0; tt < 32; ++tt) {
        s0 += f0[tt + W - 1]; s1 += f1[tt + W - 1];
        const int t = t0 + tt; const float inv = 1.f / (float)((t + 1 < W) ? (t + 1) : W);
        *(unsigned*)pp = pk2(s0 * inv - f0[tt + W - 1], s1 * inv - f1[tt + W - 1]); pp += 512; OPQ(pp);
        s0 -= f0[tt]; s1 -= f1[tt];
    }
}
__device__ __forceinline__ void phase_p2(Frame& F, int l) {
    const int tid = F.tid, half = __builtin_amdgcn_readfirstlane(tid >> 8), c = 2 * (tid & 255), lane = F.lane, wave = F.wave;
    unsigned char* ws = F.ws;
    const bf16_t* Abuf = (const bf16_t*)(ws + WS_ABUF); const bf16_t* Ubuf = (const bf16_t*)(ws + WS_UBUF); const bf16_t* CXC = (const bf16_t*)(ws + WS_CXC); bf16_t* CB = (bf16_t*)(ws + WS_CB);
    bf16_t* Aact = (bf16_t*)(ws + WS_AACT); bf16_t* Pin = (bf16_t*)(ws + WS_PIN);
    const float* cw = inptr(F, I_CONV_A_W) + l * 31 * 512; const float* cb = inptr(F, I_CONV_A_B) + l * 512;
    const float* lg = inptr(F, I_LN_A_G) + l * 512; const float* lb = inptr(F, I_LN_A_B) + l * 512; const float* ccw = inptr(F, I_CONV_C_W) + l * 3 * 512;
    LAS float* V = (LAS float*)F.lds;
    for (int seg = blockIdx.x; seg < NTOK / 64; seg += F.G) {
        const int b = seg >> 5, ts = (seg & 31) * 64;
        const size_t seq0 = (size_t)b * SEQ;
        const int t0 = ts + 32 * half;
        {
            const int ch = tid;
            float w[31];
#pragma unroll
            for (int k = 0; k < 31; ++k) w[k] = cw[k * 512 + ch];
            const float bias = cb[ch];
#pragma unroll 1
            for (int hp = 0; hp < 2; ++hp) {
                const int tb = ts + 32 * hp;
                float x[62];
                const bf16_t* src = Abuf + ((ptrdiff_t)seq0 + tb - 30) * 512 + ch;
#pragma unroll
                for (int i = 0; i < 62; ++i) { const unsigned short hv = *src; src += 512; OPQ(src); x[i] = (tb - 30 + i < 0) ? 0.f : __uint_as_float((unsigned)hv << 16); }
                LAS float* vp = V + (32 * hp) * 512 + ch;
#pragma unroll
                for (int o = 0; o < 32; ++o) {
                    float a0 = bias;
#pragma unroll
                    for (int k = 0; k < 31; ++k) a0 += w[k] * x[o + k];
                    vp[o * 512] = a0;
                }
            }
        }
        {
            const bf16_t* U = Ubuf + seq0 * 512; bf16_t* P = Pin + seq0 * 512; const int g = __builtin_amdgcn_readfirstlane((tid & 255) >> 6);
            if (g == 0) pool_half<2>(U, P, t0, c); else if (g == 1) pool_half<4>(U, P, t0, c); else if (g == 2) pool_half<8>(U, P, t0, c); else pool_half<16>(U, P, t0, c);
        }
        {
            const f32x2 k0 = *(const f32x2*)(ccw + c), k1 = *(const f32x2*)(ccw + 512 + c), k2 = *(const f32x2*)(ccw + 1024 + c);
            const bf16_t* xp = CXC + ((ptrdiff_t)seq0 + t0 - 2) * 512 + c; bf16_t* Bp = CB + (seq0 + t0) * 512 + c; const bf16_t* bp = Bp;
            unsigned xv[34], bv[32];
#pragma unroll
            for (int i = 0; i < 34; ++i) { const unsigned wv = *(const unsigned*)xp; xp += 512; OPQ(xp); xv[i] = (t0 - 2 + i < 0) ? 0u : wv; }
#pragma unroll
            for (int i = 0; i < 32; ++i) { bv[i] = *(const unsigned*)bp; bp += 512; OPQ(bp); }
#pragma unroll
            for (int tt = 0; tt < 32; ++tt) {
                const float v0 = k0.x * bf_lo(xv[tt]) + k1.x * bf_lo(xv[tt + 1]) + k2.x * bf_lo(xv[tt + 2]), v1 = k0.y * bf_hi(xv[tt]) + k1.y * bf_hi(xv[tt + 1]) + k2.y * bf_hi(xv[tt + 2]);
                *(unsigned*)Bp = pk2(bf_lo(bv[tt]) * v0, bf_hi(bv[tt]) * v1); Bp += 512; OPQ(Bp);
            }
        }
        __syncthreads();
        {
            const f32x4 g0 = *(const f32x4*)(lg + 8 * lane), g1 = *(const f32x4*)(lg + 8 * lane + 4), b0 = *(const f32x4*)(lb + 8 * lane), b1 = *(const f32x4*)(lb + 8 * lane + 4);
            for (int i = 0; i < 8; ++i) {
                const int tok = wave * 8 + i;
                const f32x4 v0 = *(const LAS f32x4*)(V + tok * 512 + 8 * lane), v1 = *(const LAS f32x4*)(V + tok * 512 + 8 * lane + 4);
                const float mu = wave_sum((v0[0] + v0[1]) + (v0[2] + v0[3]) + (v1[0] + v1[1]) + (v1[2] + v1[3])) * (1.f / 512.f);
                const f32x4 d0 = v0 - mu, d1 = v1 - mu;
                const float var = wave_sum((d0[0] * d0[0] + d0[1] * d0[1]) + (d0[2] * d0[2] + d0[3] * d0[3]) + (d1[0] * d1[0] + d1[1] * d1[1]) + (d1[2] * d1[2] + d1[3] * d1[3])) * (1.f / 512.f);
                const float rs = rsqrtf(var + EPS);
                f32x4 y0 = d0 * rs * g0 + b0, y1 = d1 * rs * g1 + b1;
                y0[0] *= sigm(y0[0]); y0[1] *= sigm(y0[1]); y0[2] *= sigm(y0[2]); y0[3] *= sigm(y0[3]); y1[0] *= sigm(y1[0]); y1[1] *= sigm(y1[1]); y1[2] *= sigm(y1[2]); y1[3] *= sigm(y1[3]);
                u32x4 w; w.x = pk2(y0[0], y0[1]); w.y = pk2(y0[2], y0[3]); w.z = pk2(y1[0], y1[1]); w.w = pk2(y1[2], y1[3]);
                *(u32x4*)(Aact + (seq0 + ts + tok) * 512 + 8 * lane) = w;
            }
        }
        __syncthreads();
    }
}


struct SchedKV {
    const unsigned char* ws; unsigned memb, wkv; unsigned lda, ldb; int mask, G, c;
    __device__ __forceinline__ bool next(int i, g8::Unit& u) const {
        int L = i * G + c; const int nl = ((mask & 1) ? 1 : 0) + ((mask & 2) ? 1 : 0); if (L >= 64 * nl) return false;
        int kl = (mask & 1) ? 0 : 1; if (L >= 64) { L -= 64; kl = 1; }
        const unsigned w = wkv + (unsigned)kl * 2u * 1024u * 2048u;
        if (L < 32) { u.pm = L >> 2; u.pn = L & 3; u.A = memb + (unsigned)u.pm * 256u * 2048u; u.B = w + (unsigned)u.pn * 256u * 2048u; u.kind = 2 * kl; }
        else { L -= 32; u.pm = L >> 3; u.pn = L & 7; u.A = w + 1024u * 2048u + (unsigned)u.pm * 256u * 2048u; u.B = memb + (unsigned)u.pn * 256u * 2048u; u.kind = 2 * kl + 1; }
        u.nt = 16; return true;
    }
};
struct EpiKV {
    bf16_t* KV;
    __device__ __forceinline__ void operator()(f32x4 (&acc)[2][2][4][2], const g8::Unit& u, int wr, int wc, int fr, int fq) const {
        bf16_t* base = KV + (size_t)(u.kind >> 1) * 4 * 1024 * 1024;
        const int sfq = (fq == 1) ? 2 : (fq == 2 ? 1 : fq);
#pragma unroll
        for (int ai = 0; ai < 2; ++ai)
#pragma unroll
            for (int m = 0; m < 4; ++m) {
                const int row = u.pm * 256 + ai * 128 + wr * 64 + m * 16 + fr;
#pragma unroll
                for (int bj = 0; bj < 2; ++bj) {
                    if ((u.kind & 1) == 0) {
                        const f32x4 a = acc[ai][bj][m][0], b = acc[ai][bj][m][1];
                        u32x4 w; w.x = pk2(a[0], a[1]); w.y = pk2(a[2], a[3]); w.z = pk2(b[0], b[1]); w.w = pk2(b[2], b[3]);
                        *(u32x4*)(base + (size_t)row * 1024 + u.pn * 256 + bj * 128 + wc * 32 + 8 * fq) = w;
                    } else {
#pragma unroll
                        for (int n = 0; n < 2; ++n) { const f32x4 a = acc[ai][bj][m][n]; u32x2 w; w.x = pk2(a[0], a[1]); w.y = pk2(a[2], a[3]);
                            *(u32x2*)(base + (size_t)2048 * 1024 + ((size_t)u.pn * 1024 + row) * 256 + bj * 128 + wc * 32 + 16 * n + 4 * sfq) = w; }
                    }
                }
            }
    }
};
struct EpiQ {
    const float* part; bf16_t* Q;
    __device__ __forceinline__ void operator()(f32x4 (&acc)[2][2][4][2], const g8::Unit& u, int wr, int wc, int fr, int fq) const {
#pragma unroll
        for (int ai = 0; ai < 2; ++ai)
#pragma unroll
            for (int m = 0; m < 4; ++m) {
                const int row = u.pm * 256 + ai * 128 + wr * 64 + m * 16 + fr;
                const f32x4 pv = *(const f32x4*)(part + (size_t)row * 16 + 4 * fq);
                float ss = (pv[0] + pv[1]) + (pv[2] + pv[3]); ss += __shfl_xor(ss, 16); ss += __shfl_xor(ss, 32);
                const float s = rsqrtf(ss * (1.f / DM) + EPS) * (0.0625f * 1.4426950408889634f);
#pragma unroll
                for (int bj = 0; bj < 2; ++bj) {
                    const f32x4 a = acc[ai][bj][m][0] * s, b = acc[ai][bj][m][1] * s;
                    u32x4 w; w.x = pk2(a[0], a[1]); w.y = pk2(a[2], a[3]); w.z = pk2(b[0], b[1]); w.w = pk2(b[2], b[3]);
                    *(u32x4*)(Q + (size_t)row * 1024 + u.pn * 256 + bj * 128 + wc * 32 + 8 * fq) = w;
                }
            }
    }
};
constexpr int ATT_ROWB = 528; static_assert(256 * ATT_ROWB <= CTRL_OFF, "attention tile image must stay below the LDS control area");
__device__ __forceinline__ void att_fill(LAS unsigned char* lds, const bf16_t* src, size_t row_stride_el, int tid) {
    const bf16_t* gp = src + (size_t)(tid >> 5) * row_stride_el + (tid & 31) * 8;
    LAS unsigned char* lp = lds + (tid >> 5) * ATT_ROWB + (tid & 31) * 16;
#pragma unroll
    for (int p0 = 0; p0 < 16; p0 += 4) {
        u32x4 v[4];
#pragma unroll
        for (int j = 0; j < 4; ++j) { v[j] = *(const u32x4*)gp; gp += 16 * row_stride_el; asm volatile("" : "+v"(gp)); }
#pragma unroll
        for (int j = 0; j < 4; ++j) { *(LAS u32x4*)lp = v[j]; lp += 16 * ATT_ROWB; asm volatile("" : "+v"(lp)); }
    }
}
__device__ __forceinline__ void phase_attn(Frame& F, int l) {
    const int tid = F.tid, lane = F.lane, wave = F.wave, r = lane & 31, hh = lane >> 5;
    const bf16_t* Q = (const bf16_t*)(F.ws + WS_Q); bf16_t* O = (bf16_t*)(F.ws + WS_O);
    const bf16_t* Kb = (const bf16_t*)(F.ws + WS_KV) + (size_t)l * 4 * 1024 * 1024; const bf16_t* Vt = Kb + (size_t)2048 * 1024;
    for (int id = blockIdx.x; id < 256; id += F.G) {
        const int xcd = id & 7, j = id >> 3, pair = xcd * 4 + (j >> 3), qb = j & 7, b = pair >> 2, h = pair & 3;
        const size_t qrow = (size_t)b * SEQ + qb * 256 + wave * 32 + r;
        att_fill(F.lds, Kb + (size_t)b * 256 * 1024 + h * 256, 1024, tid);
        __syncthreads();
        f32x16 acc[8];
        const LAS unsigned char* frag = F.lds + r * ATT_ROWB + hh * 16;
#pragma unroll
        for (int kb = 0; kb < 8; ++kb)
#pragma unroll
            for (int i = 0; i < 16; ++i) acc[kb][i] = 0.f;
        const bf16_t* qp = Q + qrow * 1024 + h * 256 + 8 * hh;
        bf16x8 qn = *(const bf16x8*)qp;
#pragma unroll 1
        for (int s = 0; s < 16; ++s) {
            const bf16x8 q = qn; if (s < 15) qn = *(const bf16x8*)(qp + 16 * (s + 1));
#pragma unroll
            for (int kb = 0; kb < 8; ++kb) { const bf16x8 a = *(const LAS bf16x8*)(frag + kb * 32 * ATT_ROWB + s * 32); acc[kb] = __builtin_amdgcn_mfma_f32_32x32x16_bf16(a, q, acc[kb], 0, 0, 0); }
        }
        float mx = acc[0][0];
#pragma unroll
        for (int kb = 0; kb < 8; ++kb)
#pragma unroll
            for (int i = 0; i < 16; ++i) mx = fmaxf(mx, acc[kb][i]);
        mx = fmaxf(mx, __shfl_xor(mx, 32));
        float sum = 0.f;
#pragma unroll
        for (int kb = 0; kb < 8; ++kb)
#pragma unroll
            for (int i = 0; i < 16; ++i) { const float p = __builtin_amdgcn_exp2f(acc[kb][i] - mx); acc[kb][i] = p; sum += p; }
        sum += __shfl_xor(sum, 32);
        const float inv = 1.f / sum;
        bf16x8 pf[16];
#pragma unroll
        for (int kb = 0; kb < 8; ++kb)
#pragma unroll
            for (int s2 = 0; s2 < 2; ++s2) { u32x4 w; w.x = pk2(acc[kb][8 * s2 + 0], acc[kb][8 * s2 + 1]); w.y = pk2(acc[kb][8 * s2 + 2], acc[kb][8 * s2 + 3]);
                w.z = pk2(acc[kb][8 * s2 + 4], acc[kb][8 * s2 + 5]); w.w = pk2(acc[kb][8 * s2 + 6], acc[kb][8 * s2 + 7]); pf[2 * kb + s2] = __builtin_bit_cast(bf16x8, w); }
        __syncthreads();
        att_fill(F.lds, Vt + ((size_t)b * 1024 + h * 256) * 256, 256, tid);
        __syncthreads();
        bf16_t* orow = O + qrow * 1024 + h * 256 + 4 * hh;
#pragma unroll 1
        for (int db = 0; db < 8; ++db) {
            f32x16 o;
#pragma unroll
            for (int i = 0; i < 16; ++i) o[i] = 0.f;
#pragma unroll
            for (int ks = 0; ks < 16; ++ks) { const bf16x8 a = *(const LAS bf16x8*)(frag + db * 32 * ATT_ROWB + ks * 32); o = __builtin_amdgcn_mfma_f32_32x32x16_bf16(a, pf[ks], o, 0, 0, 0); }
#pragma unroll
            for (int g = 0; g < 4; ++g) { u32x2 w; w.x = pk2(o[4 * g] * inv, o[4 * g + 1] * inv); w.y = pk2(o[4 * g + 2] * inv, o[4 * g + 3] * inv); *(u32x2*)(orow + 32 * db + 8 * g) = w; }
        }
        __syncthreads();
    }
}


constexpr int ECAP = 16384;
constexpr int MW_TP = 16, MW_CNT = 40, MW_TE = 64;
__device__ __forceinline__ void moe_table(Frame& F, int l) {
    if (F.tid < 16) F.MISC[MW_CNT + F.tid] = __hip_atomic_load(F.ctl + CW_ECNT + l * 64 + F.tid, __ATOMIC_RELAXED, __HIP_MEMORY_SCOPE_AGENT);
    __syncthreads();
    if (F.tid == 0) { unsigned a = 0; for (int e = 0; e < 16; ++e) { F.MISC[MW_TP + e] = a; const unsigned nt_ = (F.MISC[MW_CNT + e] + 255u) >> 8; for (unsigned k = 0; k < nt_ && a + k < 144u; ++k) F.MISC[MW_TE + a + k] = (unsigned)e; a += nt_; } F.MISC[MW_TP + 16] = a; }
    __syncthreads();
}
__device__ __forceinline__ int misc_u(volatile LAS unsigned* M, int i) { return __builtin_amdgcn_readfirstlane((int)M[i]); }
__device__ __forceinline__ int moe_expert_of_tile(volatile LAS unsigned* M, int ti) { return misc_u(M, MW_TE + ti); }

__device__ __forceinline__ void route_one(const float (&L)[20], const float (&bias)[20], float rstd, int& eg1, int& eg2, float& w1, float& w2) {
    float lg[4]; int gi = 0; float mg;
#pragma unroll
    for (int j = 0; j < 4; ++j) lg[j] = L[j] * rstd + bias[j];
    mg = lg[0];
#pragma unroll
    for (int j = 1; j < 4; ++j) if (lg[j] > mg) { mg = lg[j]; gi = j; }
    float se = 0.f;
#pragma unroll
    for (int j = 0; j < 4; ++j) se += __expf(lg[j] - mg);
    const float gval = 1.f / se;
    float le[4];
#pragma unroll
    for (int j = 0; j < 4; ++j) { const float a = L[4 + j] * rstd + bias[4 + j], b = L[8 + j] * rstd + bias[8 + j], c = L[12 + j] * rstd + bias[12 + j], d = L[16 + j] * rstd + bias[16 + j];
        le[j] = (gi == 0) ? a : (gi == 1) ? b : (gi == 2) ? c : d; }
    int e1 = 0; float m1 = le[0];
#pragma unroll
    for (int j = 1; j < 4; ++j) if (le[j] > m1) { m1 = le[j]; e1 = j; }
    int e2 = -1; float m2 = -3.0e38f;
#pragma unroll
    for (int j = 0; j < 4; ++j) if (j != e1 && le[j] > m2) { m2 = le[j]; e2 = j; }
    const float p2 = __expf(m2 - m1);
    w1 = gval / (1.f + p2); w2 = gval * p2 / (1.f + p2); eg1 = gi * 4 + e1; eg2 = gi * 4 + e2;
}
__device__ __forceinline__ void phase_router(Frame& F, int l, const float* X) {
    const int tid = F.tid, lane = F.lane, wave = F.wave, ks = lane & 7, tsub = lane >> 3;
    LAS float* WR = (LAS float*)F.lds;
    LAS unsigned* lcnt = (LAS unsigned*)(F.lds + 81920);
    LAS unsigned* ent = lcnt + 64;
    LAS float* entw = (LAS float*)(ent + 128);
    LAS float* lrstd = entw + 128;
    for (int i = tid; i < 20 * DM / 4; i += NTHREADS) ((LAS f32x4*)WR)[i] = ((const f32x4*)(F.ws + WS_WR))[i];
    float bias[20];
    { const float* brg = inptr(F, I_B_RG) + l * 4; const float* bre = inptr(F, I_B_RE) + l * 16;
#pragma unroll
      for (int j = 0; j < 4; ++j) bias[j] = brg[j];
#pragma unroll
      for (int j = 0; j < 16; ++j) bias[4 + j] = bre[j]; }
    unsigned* gcnt = F.ctl + CW_ECNT + l * 64;
    int* ROWTOK = (int*)(F.ws + WS_ROWTOK); float* ROWW = (float*)(F.ws + WS_ROWW); float* ROWRSTD = (float*)(F.ws + WS_ROWRSTD); unsigned* TOKSLOT = (unsigned*)(F.ws + WS_TOKSLOT);
    for (int chunk = blockIdx.x; chunk < NTOK / 64; chunk += F.G) {
        if (tid < 16) lcnt[tid] = 0u;
        __syncthreads();
        const int tl = wave * 8 + tsub; const size_t tok = (size_t)chunk * 64 + tl;
        const f32x4* xr = (const f32x4*)(X + tok * DM) + ks;
        float L[20]; float ss = 0.f;
#pragma unroll
        for (int j = 0; j < 20; ++j) L[j] = 0.f;
#pragma unroll 1
        for (int i0 = 0; i0 < 32; i0 += 8) {
            f32x4 xv[8];
#pragma unroll
            for (int i = 0; i < 8; ++i) xv[i] = xr[8 * (i0 + i)];
#pragma unroll
            for (int i = 0; i < 8; ++i) ss += (xv[i][0] * xv[i][0] + xv[i][1] * xv[i][1]) + (xv[i][2] * xv[i][2] + xv[i][3] * xv[i][3]);
            const LAS float* wp = WR + 4 * (ks + 8 * i0);
#pragma unroll
            for (int j = 0; j < 20; ++j) {
#pragma unroll
                for (int i = 0; i < 8; ++i) { const f32x4 w = *(const LAS f32x4*)(wp + j * 1024 + 32 * i); L[j] += (xv[i][0] * w[0] + xv[i][1] * w[1]) + (xv[i][2] * w[2] + xv[i][3] * w[3]); }
            }
        }
#pragma unroll
        for (int o = 1; o < 8; o <<= 1) { ss += __shfl_xor(ss, o);
#pragma unroll
            for (int j = 0; j < 20; ++j) L[j] += __shfl_xor(L[j], o); }
        const float rs = rsqrtf(ss * (1.f / DM) + EPS);
        int e1, e2; float w1, w2;
        route_one(L, bias, rs, e1, e2, w1, w2);
        if (ks == 0) {
            unsigned p;
            p = __hip_atomic_fetch_add(lcnt + e1, 1u, __ATOMIC_RELAXED, __HIP_MEMORY_SCOPE_WORKGROUP); ent[tl * 2 + 0] = ((unsigned)e1 << 16) | p; entw[tl * 2 + 0] = w1;
            p = __hip_atomic_fetch_add(lcnt + e2, 1u, __ATOMIC_RELAXED, __HIP_MEMORY_SCOPE_WORKGROUP); ent[tl * 2 + 1] = ((unsigned)e2 << 16) | p; entw[tl * 2 + 1] = w2;
            lrstd[tl] = rs;
        }
        __syncthreads();
        if (tid < 16) lcnt[16 + tid] = __hip_atomic_fetch_add(gcnt + tid, lcnt[tid], __ATOMIC_RELAXED, __HIP_MEMORY_SCOPE_AGENT);
        __syncthreads();
        if (tid < 128) { const int t2 = tid >> 1; const unsigned en = ent[tid], e = en >> 16, pos = lcnt[16 + e] + (en & 0xffffu); const int token = chunk * 64 + t2;
            ROWTOK[e * ECAP + pos] = token; ROWW[e * ECAP + pos] = entw[tid]; ROWRSTD[e * ECAP + pos] = lrstd[t2]; TOKSLOT[token * 2 + (tid & 1)] = (e << 20) | pos; }
        __syncthreads();
    }
}
struct SchedMoe1 {
    const unsigned char* ws; unsigned XB, W; const int* rowtok; volatile LAS unsigned* M; unsigned lda, ldb; int G, c;
    __device__ __forceinline__ bool next(int i, g8::Unit& u) const {
        const int L = i * G + c; if (L >= 2 * misc_u(M, MW_TP + 16)) return false;
        const int ti = L >> 1, pn = L & 1, e = moe_expert_of_tile(M, ti), mt = ti - misc_u(M, MW_TP + e), ne = misc_u(M, MW_CNT + e);
        u.A = XB; u.B = W + ((unsigned)e * 512u + (unsigned)pn * 256u) * 2048u; u.gth = rowtok + e * ECAP + mt * 256; u.nvalid = ne - mt * 256; u.nt = 16; u.pm = ti; u.pn = pn; u.kind = e * ECAP + mt * 256; return true;
    }
};
struct EpiMoe1 {
    const float* roww; const float* rowrstd; bf16_t* ACT;
    __device__ __forceinline__ void operator()(f32x4 (&acc)[2][2][4][2], const g8::Unit& u, int wr, int wc, int fr, int fq) const {
#pragma unroll
        for (int ai = 0; ai < 2; ++ai)
#pragma unroll
            for (int m = 0; m < 4; ++m) {
                const int rr = ai * 128 + wr * 64 + m * 16 + fr; const float s = rowrstd[u.kind + rr], w = roww[u.kind + rr];
#pragma unroll
                for (int bj = 0; bj < 2; ++bj) {
                    const f32x4 g = acc[ai][bj][m][0] * s, up = acc[ai][bj][m][1] * s; f32x4 r;
                    r[0] = g[0] * sigm(g[0]) * up[0] * w; r[1] = g[1] * sigm(g[1]) * up[1] * w; r[2] = g[2] * sigm(g[2]) * up[2] * w; r[3] = g[3] * sigm(g[3]) * up[3] * w;
                    u32x2 o; o.x = pk2(r[0], r[1]); o.y = pk2(r[2], r[3]);
                    *(u32x2*)(ACT + ((size_t)u.pm * 256 + rr) * 256 + 128 * u.pn + ((bj * 128 + wc * 32 + 8 * fq) >> 1)) = o;
                }
            }
    }
};
struct SchedMoe2 {
    const unsigned char* ws; unsigned ACT, W; volatile LAS unsigned* M; unsigned lda, ldb; int G, c;
    __device__ __forceinline__ bool next(int i, g8::Unit& u) const {
        const int L = i * G + c; if (L >= 4 * misc_u(M, MW_TP + 16)) return false;
        const int ti = L >> 2, pn = L & 3, e = moe_expert_of_tile(M, ti);
        u.A = ACT + (unsigned)ti * 256u * 512u; u.B = W + ((unsigned)e * 1024u + (unsigned)pn * 256u) * 512u; u.nt = 4; u.pm = ti; u.pn = pn; u.kind = 0; return true;
    }
};
struct EpiY {
    bf16_t* Y;
    __device__ __forceinline__ void operator()(f32x4 (&acc)[2][2][4][2], const g8::Unit& u, int wr, int wc, int fr, int fq) const {
#pragma unroll
        for (int ai = 0; ai < 2; ++ai)
#pragma unroll
            for (int m = 0; m < 4; ++m) {
                const size_t row = (size_t)u.pm * 256 + ai * 128 + wr * 64 + m * 16 + fr;
#pragma unroll
                for (int bj = 0; bj < 2; ++bj) { const f32x4 a = acc[ai][bj][m][0], b = acc[ai][bj][m][1];
                    u32x4 w; w.x = pk2(a[0], a[1]); w.y = pk2(a[2], a[3]); w.z = pk2(b[0], b[1]); w.w = pk2(b[2], b[3]);
                    *(u32x4*)(Y + row * 1024 + u.pn * 256 + bj * 128 + wc * 32 + 8 * fq) = w; }
            }
    }
};
__device__ __forceinline__ void phase_combine(Frame& F, float* X, bool last) {
    const int gw = F.vcu * NWAVES + F.wave, NGW = F.G * NWAVES, lane = F.lane;
    const unsigned* TOKSLOT = (const unsigned*)(F.ws + WS_TOKSLOT); const bf16_t* Y = (const bf16_t*)(F.ws + WS_Y);
    const float* gf = inptr(F, I_NORM_F_G);
    for (int m = gw; m < NTOK; m += NGW) {
        const unsigned s0 = TOKSLOT[2 * m], s1 = TOKSLOT[2 * m + 1];
        const size_t r0 = (size_t)F.MISC[MW_TP + (s0 >> 20)] * 256 + (s0 & 0xfffffu), r1 = (size_t)F.MISC[MW_TP + (s1 >> 20)] * 256 + (s1 & 0xfffffu);
        f32x4* xr = (f32x4*)(X + (size_t)m * DM) + lane; const u32x2* y0 = (const u32x2*)(Y + r0 * DM) + lane; const u32x2* y1 = (const u32x2*)(Y + r1 * DM) + lane;
        f32x4 v[4]; float ss = 0.f;
#pragma unroll
        for (int j = 0; j < 4; ++j) { const u32x2 a = y0[64 * j], b = y1[64 * j]; f32x4 x = xr[64 * j];
            x[0] += bf_lo(a.x) + bf_lo(b.x); x[1] += bf_hi(a.x) + bf_hi(b.x); x[2] += bf_lo(a.y) + bf_lo(b.y); x[3] += bf_hi(a.y) + bf_hi(b.y);
            v[j] = x; ss += (x[0] * x[0] + x[1] * x[1]) + (x[2] * x[2] + x[3] * x[3]); }
        const float rstd = rsqrtf(wave_sum(ss) * (1.f / DM) + EPS);
        if (last) {
#pragma unroll
            for (int j = 0; j < 4; ++j) { const f32x4 g = *((const f32x4*)gf + lane + 64 * j); xr[64 * j] = v[j] * rstd * g; }
        } else {
            if (lane == 0) ((float*)(F.ws + WS_RSTD_MIX))[m] = rstd;
            u32x2* xb = (u32x2*)((bf16_t*)(F.ws + WS_XB) + (size_t)m * DM) + lane;
#pragma unroll
            for (int j = 0; j < 4; ++j) { xr[64 * j] = v[j]; u32x2 w; w.x = pk2(v[j][0], v[j][1]); w.y = pk2(v[j][2], v[j][3]); xb[64 * j] = w; }
        }
    }
}

enum { PH_PREP = 0, PH_KV, PH_P1, PH_P2, PH_P3, PH_P4, PH_P5, PH_P6, PH_P7, PH_P8, PH_P9, PH_P10, PH_P11, PH_COUNT };

__global__ void __launch_bounds__(NTHREADS, 2) mega(Args args) {
    extern __shared__ __attribute__((aligned(16))) unsigned char lds_raw[];
    Frame F;
    F.lds = (LAS unsigned char*)lds_raw; F.MISC = (volatile LAS unsigned*)(F.lds + MISC_OFF);
    F.tid = threadIdx.x; F.lane = F.tid & 63; F.wave = __builtin_amdgcn_readfirstlane(F.tid >> 6);
    F.G = gridDim.x; { const int bx = blockIdx.x; F.vcu = (F.G % 8 == 0) ? (bx % 8) * (F.G / 8) + bx / 8 : bx; }
    F.ws = args.ws; F.ctl = (unsigned*)(args.ws + WS_CTL);
    for (int u = F.tid; u < (PTAB_OFF - MISC_OFF) / 4; u += NTHREADS) F.MISC[u] = 0u;
    if (F.tid < 28) ((LAS unsigned long long*)(F.lds + PTAB_OFF))[F.tid] = (unsigned long long)args.in[F.tid];
    __syncthreads();
    const bool fused = (args.flags & 8) != 0;
    XcdBarrier bar; bar.bar = F.ctl + CW_BAR; bar.x = 0; bar.st = nullptr;
    if (fused) bar = xcd_barrier_post(F.ctl + CW_BAR, F.MISC + 8);
    const int lo = args.ph_lo, hi = args.ph_hi;
    const int l_lo = fused ? 0 : args.layer, l_hi = fused ? 2 : args.layer + 1;
#define IN(k) (lo <= (k) && (k) < hi)
#ifdef PROBE_MASK
    int n_stamp = 0;
#define STAMP() do { if (blockIdx.x == 0 && F.tid == 0) { const unsigned long long t_ = __builtin_amdgcn_s_memrealtime(); F.MISC[256 + 2 * n_stamp] = (unsigned)t_; F.MISC[257 + 2 * n_stamp] = (unsigned)(t_ >> 32); } ++n_stamp; } while (0)
    STAMP();
#else
#define STAMP() do { } while (0)
#endif
#define SEAM() do { if (fused) xcd_barrier(bar); LAUNDER(); STAMP(); } while (0)
#define LAUNDER() do { unsigned char* w_ = F.ws; asm volatile("" : "+s"(w_)); F.ws = w_; F.ctl = (unsigned*)(w_ + WS_CTL); int t_ = F.tid; asm volatile("" : "+v"(t_)); F.tid = t_; F.lane = t_ & 63; F.wave = __builtin_amdgcn_readfirstlane(t_ >> 6); } while (0)
#pragma unroll
    for (int l = 0; l < 2; ++l) { if (l < l_lo || l >= l_hi) continue;
    if (IN(PH_PREP) && !(fused && l == 1)) {
        const float* xsrc = (l == 0) ? inptr(F, I_X) : ((args.flags & 2) ? (const float*)args.out : nullptr);
        phase_prep(F, l, xsrc, l == 0 || (args.flags & 4), (args.flags & 1) ? (l == 0 ? 3 : 0) : (1 << l));
        SEAM();
    }
    if (IN(PH_KV) && (l == 0 || !(args.flags & 1))) {
        SchedKV S{F.ws, (unsigned)WS_MEMB, (unsigned)WS_WKV_T, 2048u, 2048u, (args.flags & 1) ? 3 : (1 << l), F.G, (int)blockIdx.x};
        EpiKV E{(bf16_t*)(F.ws + WS_KV)};
        g8::gemm_phase(F.lds, S, E);
        SEAM();
    }
    if (IN(PH_P1)) {
        SchedGrid S{F.ws, (unsigned)WS_XB, (unsigned)WS_WIN_T, 2048u, 2048u, 64, 24, 16, F.G, (int)blockIdx.x};
        EpiInProj E{(const float*)(F.ws + WS_RSTD_MIX), (bf16_t*)(F.ws + WS_ABUF), (bf16_t*)(F.ws + WS_UBUF), (bf16_t*)(F.ws + WS_CXC), (bf16_t*)(F.ws + WS_CB), (bf16_t*)(F.ws + WS_G)};
        g8::gemm_phase(F.lds, S, E);
        SEAM();
    }
    if (IN(PH_P2)) { phase_p2(F, l); SEAM(); }
    if (IN(PH_P3)) {
        SchedMerge S{F.ws, (unsigned)WS_AACT, (unsigned)WS_PIN, (unsigned)WS_CB, (unsigned)WS_WA_T, (unsigned)WS_WP_T, (unsigned)WS_WC_T, 1024u, 1024u, F.G, (int)blockIdx.x};
        EpiMerge E{(const bf16_t*)(F.ws + WS_G), (bf16_t*)(F.ws + WS_MERGED)};
        g8::gemm_phase(F.lds, S, E);
        SEAM();
    }
    if (IN(PH_P4)) {
        const float* xin = (l == 0) ? inptr(F, I_X) : args.out;
        SchedGrid S{F.ws, (unsigned)WS_MERGED, (unsigned)WS_WO_T, 2048u, 2048u, 64, 4, 16, F.G, (int)blockIdx.x};
        EpiResid E{xin, args.out, (bf16_t*)(F.ws + WS_XB), (float*)(F.ws + WS_PART)};
        g8::gemm_phase(F.lds, S, E);
        SEAM();
    }
    if (IN(PH_P5)) {
        SchedGrid S{F.ws, (unsigned)WS_XB, (unsigned)WS_WQ_T, 2048u, 2048u, 64, 4, 16, F.G, (int)blockIdx.x};
        EpiQ E{(const float*)(F.ws + WS_PART), (bf16_t*)(F.ws + WS_Q)};
        g8::gemm_phase(F.lds, S, E);
        SEAM();
    }
    if (IN(PH_P6)) { phase_attn(F, l); SEAM(); }
    if (IN(PH_P7)) {
        SchedGrid S{F.ws, (unsigned)WS_O, (unsigned)WS_WXO_T, 2048u, 2048u, 64, 4, 16, F.G, (int)blockIdx.x};
        EpiResid E{args.out, args.out, (bf16_t*)(F.ws + WS_XB), nullptr};
        g8::gemm_phase(F.lds, S, E);
        SEAM();
    }
    if (IN(PH_P8)) { phase_router(F, l, args.out); SEAM(); }
    if (IN(PH_P9)) {
        moe_table(F, l);
        SchedMoe1 S{F.ws, (unsigned)WS_XB, (unsigned)WS_WGU_T, (const int*)(F.ws + WS_ROWTOK), F.MISC, 2048u, 2048u, F.G, (int)blockIdx.x};
        EpiMoe1 E{(const float*)(F.ws + WS_ROWW), (const float*)(F.ws + WS_ROWRSTD), (bf16_t*)(F.ws + WS_ACT)};
        g8::gemm_phase_t<true>(F.lds, S, E);
        SEAM();
    }
    if (IN(PH_P10)) {
        moe_table(F, l);
        SchedMoe2 S{F.ws, (unsigned)WS_ACT, (unsigned)WS_WD_T, F.MISC, 512u, 512u, F.G, (int)blockIdx.x};
        EpiY E{(bf16_t*)(F.ws + WS_Y)};
        g8::gemm_phase(F.lds, S, E);
        SEAM();
    }
    if (IN(PH_P11)) {
        moe_table(F, l); phase_combine(F, args.out, l == 1);
        if (fused && l == 0) { phase_prep(F, 1, nullptr, false, 0); SEAM(); }
    }
    }
#ifdef PROBE_MASK
    STAMP();
    if (blockIdx.x == 0 && F.tid == 0) {
        unsigned long long tot = 0;
        for (int k = 0; k + 1 < n_stamp; ++k) if ((PROBE_MASK >> k) & 1u) { const unsigned long long a = ((unsigned long long)F.MISC[257 + 2 * k] << 32) | F.MISC[256 + 2 * k], b = ((unsigned long long)F.MISC[259 + 2 * k] << 32) | F.MISC[258 + 2 * k]; tot += b - a; }
        const unsigned long long t0 = __builtin_amdgcn_s_memrealtime();
        while (__builtin_amdgcn_s_memrealtime() - t0 < tot * PROBE_MULT) __builtin_amdgcn_s_sleep(16);
    }
#endif
#undef IN
#undef SEAM
}
}

static int g_grid = 0;
extern "C" void kernel_launch(void* const* d_in, const int* in_sizes, int n_in, void* d_out, int out_size, void* d_ws, size_t ws_size, hipStream_t stream) {
    if (g_grid == 0) {
        int dev = 0, cus = 0, per_cu = 0;
        if (n_in != 28 || ws_size < mk::WS_END || out_size != mk::NTOK * mk::DM) { fprintf(stderr, "kernel_launch: unexpected n_in %d / ws_size %zu / out_size %d\n", n_in, ws_size, out_size); g_grid = -1; return; }
        (void)hipGetDevice(&dev); (void)hipDeviceGetAttribute(&cus, hipDeviceAttributeMultiprocessorCount, dev);
        if (hipFuncSetAttribute((const void*)mk::mega, hipFuncAttributeMaxDynamicSharedMemorySize, mk::LDS_BYTES) != hipSuccess) { fprintf(stderr, "hipFuncSetAttribute failed\n"); g_grid = -1; return; }
        if (hipOccupancyMaxActiveBlocksPerMultiprocessor(&per_cu, (const void*)mk::mega, mk::NTHREADS, mk::LDS_BYTES) != hipSuccess || per_cu < 1) { fprintf(stderr, "occupancy query: %d workgroups per CU\n", per_cu); g_grid = -1; (void)hipGetLastError(); return; }
        g_grid = cus > 0 ? cus : 256;
    }
    if (g_grid < 0) return;
    (void)hipMemsetAsync((char*)d_ws + mk::WS_CTL, 0, mk::CTL_BYTES, stream);
    mk::Args a{};
    for (int i = 0; i < 28; ++i) a.in[i] = (const float*)d_in[i];
    a.out = (float*)d_out; a.ws = (unsigned char*)d_ws; a.ph_lo = 0; a.ph_hi = mk::PH_COUNT; a.layer = 0; a.flags = 1 | 8;
    hipLaunchKernelGGL(mk::mega, dim3(g_grid), dim3(mk::NTHREADS), mk::LDS_BYTES, stream, a);
}
```

```cpp
#include <hip/hip_runtime.h>
#include <cstdio>
#include <cstdint>

namespace mk {
#define LAS __attribute__((address_space(3)))
typedef unsigned short bf16_t;
typedef short bf16x8 __attribute__((ext_vector_type(8)));
typedef float f32x4 __attribute__((ext_vector_type(4)));
typedef float f32x2 __attribute__((ext_vector_type(2)));
typedef float f32x16 __attribute__((ext_vector_type(16)));
typedef unsigned u32x4 __attribute__((ext_vector_type(4)));
typedef unsigned u32x2 __attribute__((ext_vector_type(2)));
typedef __bf16 bf16x2_t __attribute__((ext_vector_type(2)));

constexpr int NTHREADS = 512, NWAVES = 8;
constexpr int RING_BYTES = 131072, CTRL_OFF = 135168  , MISC_OFF = CTRL_OFF + 320, LDS_BYTES = CTRL_OFF + 12288;
constexpr int NTOK = 16384, DM = 1024, SEQ = 2048;
constexpr float EPS = 1e-6f;

__device__ __forceinline__ unsigned pk2(float lo, float hi) { f32x2 v = {lo, hi}; bf16x2_t b = __builtin_convertvector(v, bf16x2_t); return __builtin_bit_cast(unsigned, b); }
__device__ __forceinline__ float bf_lo(unsigned w) { return __uint_as_float(w << 16); }
__device__ __forceinline__ float bf_hi(unsigned w) { return __uint_as_float(w & 0xffff0000u); }
__device__ __forceinline__ float sigm(float v) { return __builtin_amdgcn_rcpf(1.f + __builtin_amdgcn_exp2f(-1.4426950408889634f * v)); }

#define XB_TMO      128
#define XB_XCNT(j)  (256  + 64 * (j))
#define XB_XSUB(j)  (1280 + 64 * (j))
#define XB_XGEN(j)  (2304 + 64 * (j))
#define XB_TOP      3328
#define XB_TOPGEN   3392
#define XCD_BAR_WORDS 3456
#define XB_SPIN_CAP (1u << 18)
__device__ __forceinline__ unsigned xb_ld(unsigned* p)              { return __hip_atomic_load(p, __ATOMIC_RELAXED, __HIP_MEMORY_SCOPE_AGENT); }
__device__ __forceinline__ unsigned xb_add(unsigned* p, unsigned v) { return __hip_atomic_fetch_add(p, v, __ATOMIC_RELAXED, __HIP_MEMORY_SCOPE_AGENT); }
__device__ __forceinline__ unsigned xb_xcc_id() { return (unsigned)__builtin_amdgcn_s_getreg((3 << 11) | 20) & 0xFu; }
#define XB_SPIN(cond, bar) do { unsigned _sp = 0; while (cond) { __builtin_amdgcn_s_sleep(1); \
    if ((++_sp & 255u) == 0u) { if (xb_ld(&(bar)[XB_TMO])) break; if (_sp > XB_SPIN_CAP) { atomicAdd(&(bar)[XB_TMO], 1u); break; } } } } while (0)
struct XcdBarrier { unsigned* bar; unsigned x; volatile LAS unsigned* st; };
__device__ __forceinline__ XcdBarrier xcd_barrier_post(unsigned* bar, volatile LAS unsigned* st) {
    XcdBarrier b; b.bar = bar; b.x = xb_xcc_id(); b.st = st;
    if (threadIdx.x == 0) (void)xb_add(&bar[XB_XCNT(b.x)], 1u);
    return b;
}
__device__ __forceinline__ void xcd_barrier_complete(unsigned* bar, unsigned x, unsigned& nloc, unsigned& nx) {
    const unsigned G = gridDim.x * gridDim.y * gridDim.z;
    unsigned sum, cnt, mine, sp = 0u;
    for (;;) {
        sum = 0u; cnt = 0u; mine = 0u;
#pragma unroll
        for (unsigned j = 0; j < 16; ++j) { const unsigned c = xb_ld(&bar[XB_XCNT(j)]); sum += c; cnt += (c > 0u) ? 1u : 0u; mine = (j == x) ? c : mine; }
        if (sum == G) break;
        __builtin_amdgcn_s_sleep(1);
        if ((++sp & 255u) == 0u) { if (xb_ld(&bar[XB_TMO])) break; if (sp > XB_SPIN_CAP) { atomicAdd(&bar[XB_TMO], 1u); break; } }
    }
    nloc = mine > 0u ? mine : 1u; nx = cnt > 0u ? cnt : 1u;
}
__device__ __forceinline__ void xcd_barrier(const XcdBarrier& b) {
    asm volatile("s_waitcnt vmcnt(0)" ::: "memory");
    __syncthreads();
    if (threadIdx.x == 0) {
        unsigned* bar = b.bar;
        __builtin_amdgcn_s_waitcnt(0);
        unsigned nloc = b.st[0], nx = b.st[1];
        if (nloc == 0u) { xcd_barrier_complete(bar, b.x, nloc, nx); b.st[0] = nloc; b.st[1] = nx; }
        const unsigned old = xb_add(&bar[XB_XSUB(b.x)], 1u);
        const unsigned gen = old / nloc;
        if (old + 1u == (gen + 1u) * nloc) {
            __builtin_amdgcn_fence(__ATOMIC_RELEASE, "agent");
            asm volatile("s_waitcnt vmcnt(0)" ::: "memory");
            const unsigned og = xb_add(&bar[XB_TOP], 1u);
            const unsigned tg = og / nx;
            if (og + 1u == (tg + 1u) * nx) xb_add(&bar[XB_TOPGEN], 1u);
            else XB_SPIN(xb_ld(&bar[XB_TOPGEN]) == tg, bar);
            __builtin_amdgcn_fence(__ATOMIC_ACQUIRE, "agent");
            xb_add(&bar[XB_XGEN(b.x)], 1u);
            asm volatile("s_waitcnt vmcnt(0)" ::: "memory");
        } else {
            XB_SPIN(xb_ld(&bar[XB_XGEN(b.x)]) == gen, bar);
            __builtin_amdgcn_fence(__ATOMIC_ACQUIRE, "agent");
            asm volatile("s_waitcnt vmcnt(0)" ::: "memory");
        }
    }
    __syncthreads();
}

namespace g8 {
constexpr int BM = 256, BK = 64, HALF = 128, HTB = HALF * BK * 2, STAGE_BYTES = 8 * HTB, NXCD = 8, WGM = 8;
__device__ __forceinline__ int lds_byte(int r, int c) { const int st = (r >> 4) * 2 + (c >> 5), rr = r & 15, cc = c & 31, ob = rr * 64 + cc * 2; return st * 1024 + (ob ^ (((ob >> 9) & 1) << 5)); }
__device__ __forceinline__ void stage_rc(int b, int& R, int& C) { const int st = b / 1024, sb = b % 1024, swz = sb ^ (((sb >> 9) & 1) << 5); R = (st >> 1) * 16 + swz / 64; C = (st & 1) * 32 + (swz % 64) / 2; }

struct Unit { unsigned A, B; const int* gth; int nt, pm, pn, kind, nvalid; };

__device__ __forceinline__ bool static_tile(int nM, int nN, int G, int c, int i, int& pm, int& pn) {
    const int nwg = nM * nN; const long L = (long)i * G + c; if (L >= nwg) return false;
    int wgid = (int)L; { const int q = nwg / NXCD, r = nwg % NXCD, xcd = wgid % NXCD, off = wgid / NXCD; wgid = (xcd < r ? xcd * (q + 1) : r * (q + 1) + (xcd - r) * q) + off; }
    const int nig = WGM * nN, gid = wgid / nig, fm = gid * WGM, gsz = (nM - fm) < WGM ? (nM - fm) : WGM;
    pm = fm + ((wgid % nig) % gsz); pn = (wgid % nig) / gsz; return true;
}

template <bool GATHER, class Epi, class Sched>
__device__ __forceinline__ void gemm_phase_t(LAS unsigned char* lds, const Sched& S, const Epi& E) {
    int tid_ = threadIdx.x; asm volatile("" : "+v"(tid_));
    const int tid = tid_, wid = __builtin_amdgcn_readfirstlane(tid >> 6), lane = tid & 63, wr = wid >> 2, wc = wid & 3, fr = lane & 15, fq = lane >> 4;
    const unsigned lda = S.lda, ldb = S.ldb;
    unsigned voffA[2], voffB[2], voffA1[2];
#pragma unroll
    for (int i = 0; i < 2; ++i) { int R, C; stage_rc(tid * 16 + i * 8192, R, C); voffA[i] = (unsigned)R * lda + (unsigned)C * 2u; voffB[i] = (unsigned)R * ldb + (unsigned)C * 2u; voffA1[i] = voffA[i]; }
    constexpr int GOFF_OFF = CTRL_OFF + 4096;
#define G8_GOFF(u, o0, o1) do { _Pragma("unroll") for (int _i = 0; _i < 2; ++_i) { int R_, C_; stage_rc(tid * 16 + _i * 8192, R_, C_); const int r0_ = R_, r1_ = 128 + R_; \
        const int t0_ = (r0_ < (u).nvalid) ? (u).gth[r0_] : 0, t1_ = (r1_ < (u).nvalid) ? (u).gth[r1_] : 0; \
        o0[_i] = (unsigned)t0_ * lda + (unsigned)C_ * 2u; o1[_i] = (unsigned)t1_ * lda + (unsigned)C_ * 2u; asm volatile("" : "+v"(o0[_i]), "+v"(o1[_i])); } } while (0)
    const unsigned kstep = (unsigned)(BK * 2);
    const unsigned hsA = GATHER ? 0u : (unsigned)HALF * lda, hsB = (unsigned)HALF * ldb;
    const __amdgpu_buffer_rsrc_t rsrc = __builtin_amdgcn_make_buffer_rsrc((void*)S.ws, 0, 0x7ffffff0, 0x00020000);
    const unsigned ldsw = (unsigned)wid * 1024u;
    const int aoff = lds_byte(wr * 64 + fr, fq * 8), boff = lds_byte(wc * 32 + fr, fq * 8);
#define G8_SA(b, h) (((b) * 2 + (h)) * HTB)
#define G8_SB(b, h) ((4 + (b) * 2 + (h)) * HTB)
#define G8_STAGE(bufoff, gbase, voff) do { _Pragma("unroll") for (int _i = 0; _i < 2; ++_i) \
        __builtin_amdgcn_raw_ptr_buffer_load_lds(rsrc, (LAS void*)(lds + (bufoff) + ldsw + _i * 8192), 16, (int)(voff)[_i], (int)(gbase), 0, 0); } while (0)
#define G8_LDA(dst, b, h) do { _Pragma("unroll") for (int m = 0; m < 4; ++m) _Pragma("unroll") for (int k = 0; k < 2; ++k) dst[m][k] = *(const LAS bf16x8*)(lds + G8_SA(b, h) + aoff + m * 2048 + k * 1024); } while (0)
#define G8_LDB(dst, b, h) do { _Pragma("unroll") for (int n = 0; n < 2; ++n) _Pragma("unroll") for (int k = 0; k < 2; ++k) dst[n][k] = *(const LAS bf16x8*)(lds + G8_SB(b, h) + boff + n * 2048 + k * 1024); } while (0)
#define G8_MMA(ai, bj, At, Bt) do { __builtin_amdgcn_s_setprio(1); _Pragma("unroll") for (int m = 0; m < 4; ++m) _Pragma("unroll") for (int n = 0; n < 2; ++n) _Pragma("unroll") for (int k = 0; k < 2; ++k) \
        acc[ai][bj][m][n] = __builtin_amdgcn_mfma_f32_16x16x32_bf16(Bt[n][k], At[m][k], acc[ai][bj][m][n], 0, 0, 0); __builtin_amdgcn_s_setprio(0); } while (0)
#define G8_WAIT_V(n) asm volatile("s_waitcnt vmcnt(" #n ")" ::: "memory")
#define G8_WAIT_L(n) asm volatile("s_waitcnt lgkmcnt(" #n ")" ::: "memory")
#define G8_BAR __builtin_amdgcn_s_barrier()
#define G8_SCHED __builtin_amdgcn_sched_barrier(0)
    Unit cur, nxt; int ui = 0;
    if (!S.next(0, cur)) return;
    f32x4 acc[2][2][4][2];
#pragma unroll
    for (int a = 0; a < 2; ++a)
#pragma unroll
        for (int b = 0; b < 2; ++b)
#pragma unroll
            for (int m = 0; m < 4; ++m)
#pragma unroll
                for (int n = 0; n < 2; ++n) acc[a][b][m][n] = (f32x4){0.f, 0.f, 0.f, 0.f};
    bf16x8 At[4][2], B0[2][2], B1[2][2];
    unsigned cA = cur.A, cB = cur.B;
    if constexpr (GATHER) G8_GOFF(cur, voffA, voffA1);
    G8_STAGE(G8_SB(0, 0), cB, voffB); G8_STAGE(G8_SB(0, 1), cB + hsB, voffB); G8_STAGE(G8_SA(0, 0), cA, voffA); G8_STAGE(G8_SA(0, 1), cA + hsA, voffA1);
    if (wr == 1) G8_BAR;
    G8_WAIT_V(2); G8_BAR;
    G8_STAGE(G8_SB(1, 0), cB + kstep, voffB); G8_STAGE(G8_SA(1, 0), cA + kstep, voffA); G8_STAGE(G8_SB(1, 1), cB + hsB + kstep, voffB);
    G8_WAIT_V(6); G8_BAR;
    for (;;) {
        const bool has_next = S.next(ui + 1, nxt);
        const unsigned nA = has_next ? nxt.A : cA, nB = has_next ? nxt.B : cB;
        if constexpr (GATHER) { unsigned go0[2], go1[2]; if (has_next) G8_GOFF(nxt, go0, go1); else { go0[0] = voffA[0]; go0[1] = voffA[1]; go1[0] = voffA1[0]; go1[1] = voffA1[1]; }
            *(LAS u32x4*)(lds + GOFF_OFF + tid * 16) = (u32x4){go0[0], go0[1], go1[0], go1[1]}; }
        const int nt = cur.nt;
#pragma unroll 1
        for (int t = 0; t < nt; t += 2) {
            const bool last = (t == nt - 2);
            const unsigned a1 = cA + (unsigned)(t + 1) * kstep;
            const unsigned a2 = last ? nA : cA + (unsigned)(t + 2) * kstep, b2 = last ? nB : cB + (unsigned)(t + 2) * kstep;
            const unsigned a3 = a2 + kstep, b3 = b2 + kstep;
            unsigned o2h0[2], o2h1[2];
            if constexpr (GATHER) { o2h0[0] = voffA[0]; o2h0[1] = voffA[1]; o2h1[0] = voffA1[0]; o2h1[1] = voffA1[1];
                if (last) { const u32x4 nv_ = *(const LAS u32x4*)(lds + GOFF_OFF + tid * 16); o2h0[0] = nv_.x; o2h0[1] = nv_.y; o2h1[0] = nv_.z; o2h1[1] = nv_.w; } }
            else { o2h0[0] = voffA[0]; o2h0[1] = voffA[1]; o2h1[0] = voffA[0]; o2h1[1] = voffA[1]; }
            G8_LDB(B0, 0, 0); G8_LDB(B1, 0, 1); G8_SCHED; G8_LDA(At, 0, 0); G8_STAGE(G8_SA(1, 1), a1 + hsA, voffA1);
            G8_WAIT_V(8); G8_WAIT_L(0); G8_BAR; G8_MMA(0, 0, At, B0); G8_MMA(0, 1, At, B1); G8_BAR; G8_SCHED;
            G8_LDA(At, 0, 1); G8_STAGE(G8_SB(0, 0), b2, voffB); G8_STAGE(G8_SB(0, 1), b2 + hsB, voffB); G8_STAGE(G8_SA(0, 0), a2, o2h0);
            G8_WAIT_V(8); G8_WAIT_L(0); G8_BAR; G8_MMA(1, 0, At, B0); G8_MMA(1, 1, At, B1); G8_BAR; G8_SCHED;
            G8_LDB(B0, 1, 0); G8_LDB(B1, 1, 1); G8_SCHED; G8_LDA(At, 1, 0); G8_STAGE(G8_SA(0, 1), a2 + hsA, o2h1);
            G8_WAIT_V(8); G8_WAIT_L(0); G8_BAR; G8_MMA(0, 0, At, B0); G8_MMA(0, 1, At, B1); G8_BAR; G8_SCHED;
            G8_LDA(At, 1, 1); G8_STAGE(G8_SB(1, 0), b3, voffB); G8_STAGE(G8_SB(1, 1), b3 + hsB, voffB); G8_STAGE(G8_SA(1, 0), a3, o2h0);
            G8_WAIT_V(8); G8_WAIT_L(0); G8_BAR; G8_MMA(1, 0, At, B0); G8_MMA(1, 1, At, B1); G8_BAR; G8_SCHED;
        }
        if (wr == 0) G8_BAR;
        { int fr_ = fr, fq_ = fq; asm volatile("" : "+v"(fr_), "+v"(fq_)); E(acc, cur, wr, wc, fr_, fq_); }
        if (!has_next) break;
#pragma unroll
        for (int a = 0; a < 2; ++a)
#pragma unroll
            for (int b = 0; b < 2; ++b)
#pragma unroll
                for (int m = 0; m < 4; ++m)
#pragma unroll
                    for (int n = 0; n < 2; ++n) acc[a][b][m][n] = (f32x4){0.f, 0.f, 0.f, 0.f};
        cur = nxt; cA = nA; cB = nB; ++ui;
        if constexpr (GATHER) { const u32x4 nv_ = *(const LAS u32x4*)(lds + GOFF_OFF + tid * 16); voffA[0] = nv_.x; voffA[1] = nv_.y; voffA1[0] = nv_.z; voffA1[1] = nv_.w; }
        if (wr == 1) G8_BAR;
    }
    G8_WAIT_V(0);
    G8_BAR;
#undef G8_GOFF
#undef G8_SA
#undef G8_SB
#undef G8_STAGE
#undef G8_LDA
#undef G8_LDB
#undef G8_MMA
#undef G8_WAIT_V
#undef G8_WAIT_L
#undef G8_BAR
#undef G8_SCHED
}
template <class Epi, class Sched> __device__ __forceinline__ void gemm_phase(LAS unsigned char* lds, const Sched& S, const Epi& E) { gemm_phase_t<false, Epi, Sched>(lds, S, E); }
}

constexpr size_t MiB = 1u << 20;
constexpr size_t WS_RSTD_MIX = 1 * MiB, WS_RSTD_FFN = 1 * MiB + 65536, WS_TOKSLOT = 1 * MiB + 131072;
constexpr size_t WS_PART = 2 * MiB, WS_ROWTOK = 3 * MiB, WS_ROWW = 4 * MiB, WS_ROWRSTD = 5 * MiB, WS_WR = 6 * MiB;
constexpr size_t WS_WIN_T = 8 * MiB, WS_WA_T = 20 * MiB, WS_WP_T = 21 * MiB, WS_WC_T = 22 * MiB, WS_WO_T = 23 * MiB, WS_WQ_T = 25 * MiB, WS_WXO_T = 27 * MiB;
constexpr size_t WS_WGU_T = 29 * MiB, WS_WD_T = 45 * MiB;
constexpr size_t WS_KV = 53 * MiB;
constexpr size_t WS_XB = 69 * MiB, WS_AACT = 197 * MiB, WS_PIN = 213 * MiB;
constexpr size_t WS_ABUF = 101 * MiB, WS_UBUF = 117 * MiB, WS_CXC = 133 * MiB, WS_CB = 149 * MiB, WS_MERGED = 101 * MiB, WS_ACT = 101 * MiB;
constexpr size_t WS_G2 = 165 * MiB  , WS_WKV_T = 165 * MiB, WS_MEMB = 181 * MiB, WS_Q = 165 * MiB, WS_O = 197 * MiB, WS_Y = 165 * MiB;
constexpr size_t WS_CTL = 262 * MiB, CTL_BYTES = 1 * MiB, WS_END = 263 * MiB;
constexpr int CW_BAR = 4096;
constexpr int CW_ECNT = 8192;

struct Args {
    const float* in[28];
    float* out; unsigned char* ws;
    int ph_lo, ph_hi, layer, flags;
};
struct Frame {
    LAS unsigned char* lds; volatile LAS unsigned* MISC; unsigned* ctl;
    int tid, lane, wave, vcu, G;
    unsigned char* ws;
};
constexpr int PTAB_OFF = CTRL_OFF + 2048;
__device__ __forceinline__ const float* inptr(const Frame& F, int i) {
    const unsigned long long v = ((const LAS unsigned long long*)(F.lds + PTAB_OFF))[i];
    const unsigned lo = __builtin_amdgcn_readfirstlane((unsigned)v), hi = __builtin_amdgcn_readfirstlane((unsigned)(v >> 32));
    return (const float*)(((unsigned long long)hi << 32) | lo);
}
__device__ __forceinline__ float wave_sum(float v) {
#pragma unroll
    for (int o = 1; o < 64; o <<= 1) v += __shfl_xor(v, o);
    return v;
}

__device__ __forceinline__ int p8_logical(int p) { return (p & ~31) | (((p >> 2) & 3) << 3) | (((p >> 4) & 1) << 2) | (p & 3); }
struct ColRef { const float* p; int ld; float scale; };
template <class MapF>
__device__ __forceinline__ void prep_item(const MapF& cref, const float* gain, bf16_t* WT, int ldw, int k0, int p0, LAS float* scr, int lane) {
    const ColRef cr = cref(p0 + (lane & 31));
    const float* p = cr.p + (size_t)(k0 + (lane >> 5)) * cr.ld; const size_t step = (size_t)2 * cr.ld;
    float v[32];
#pragma unroll
    for (int i = 0; i < 32; ++i) { v[i] = *p; p += step; }
    const int c = lane & 7;
    f32x4 g0 = (f32x4){1.f, 1.f, 1.f, 1.f}, g1 = g0;
    if (gain) { g0 = *(const f32x4*)(gain + k0 + 8 * c); g1 = *(const f32x4*)(gain + k0 + 8 * c + 4); }
#pragma unroll
    for (int i = 0; i < 32; ++i) scr[(2 * i + (lane >> 5)) * 33 + (lane & 31)] = v[i] * cr.scale;
    asm volatile("s_waitcnt lgkmcnt(0)" ::: "memory");
#pragma unroll
    for (int j = 0; j < 4; ++j) { const int n = (lane >> 3) + 8 * j; const LAS float* s = scr + (8 * c) * 33 + n;
        u32x4 o; o.x = pk2(s[0 * 33] * g0[0], s[1 * 33] * g0[1]); o.y = pk2(s[2 * 33] * g0[2], s[3 * 33] * g0[3]); o.z = pk2(s[4 * 33] * g1[0], s[5 * 33] * g1[1]); o.w = pk2(s[6 * 33] * g1[2], s[7 * 33] * g1[3]);
        *(u32x4*)(WT + (size_t)(p0 + n) * ldw + k0 + 8 * c) = o; }
    asm volatile("s_waitcnt lgkmcnt(0)" ::: "memory");
}
struct MapPlain { const float* W; int ld; int off; __device__ ColRef operator()(int p) const { return ColRef{W + off + p8_logical(p), ld, 1.f}; } };
struct MapNatural { const float* W; int ld; int off; __device__ ColRef operator()(int p) const { return ColRef{W + off + p, ld, 1.f}; } };
struct MapWin { const float* W; __device__ ColRef operator()(int p) const {
    const int L = p8_logical(p), tile = L >> 8, q8 = (L & 255) >> 3, w = L & 7; int col;
    if (tile < 4) col = (w < 4 ? 0 : 512) + 128 * tile + 4 * q8 + (w & 3);
    else if (tile < 6) col = L;
    else if (tile < 10) col = (w < 4 ? 1536 : 2560) + 128 * (tile - 6) + 4 * q8 + (w & 3);
    else if (tile < 12) col = L - 512;
    else col = L;
    return ColRef{W + col, 6144, 1.f}; } };
struct MapPool { const float* W; const float* ps; __device__ ColRef operator()(int p) const {
    const int n = p8_logical(p); return ColRef{W + (size_t)(n >> 8) * 128 * 256 + (n & 255), 256, ps[n]}; } };
struct MapGU { const float* Wg; long du; __device__ ColRef operator()(int p) const {
    const int L = p8_logical(p), tile = L >> 8, q8 = (L & 255) >> 3, w = L & 7; const int ch = 128 * tile + 4 * q8 + (w & 3);
    return ColRef{Wg + (w < 4 ? 0l : du) + ch, 256, 1.f}; } };

enum { I_X = 0, I_MEM, I_NORM_MIX_G, I_W_IN, I_CONV_A_W, I_CONV_A_B, I_LN_A_G, I_LN_A_B, I_W_A_OUT, I_W_POOL, I_POOL_SCALE, I_CONV_C_W, I_W_C_OUT, I_W_O,
       I_NORM_X_G, I_NORM_MEM_G, I_W_XQ, I_W_XKV, I_W_XO, I_NORM_FFN_G, I_W_RG, I_B_RG, I_W_RE, I_B_RE, I_W_E_GATE, I_W_E_UP, I_W_E_DOWN, I_NORM_F_G };

__device__ __forceinline__ void row2_rstd_bf16(const float* xrow, bf16_t* orow, float* rstd_out, bool normalise, int lane) {
    const f32x4* xr = (const f32x4*)xrow + lane;
    f32x4 v[8]; float s0 = 0.f, s1 = 0.f;
#pragma unroll
    for (int j = 0; j < 8; ++j) v[j] = xr[64 * j];
#pragma unroll
    for (int j = 0; j < 4; ++j) { s0 += (v[j].x * v[j].x + v[j].y * v[j].y) + (v[j].z * v[j].z + v[j].w * v[j].w); s1 += (v[j + 4].x * v[j + 4].x + v[j + 4].y * v[j + 4].y) + (v[j + 4].z * v[j + 4].z + v[j + 4].w * v[j + 4].w); }
    const float r0 = rsqrtf(wave_sum(s0) * (1.f / DM) + EPS), r1 = rsqrtf(wave_sum(s1) * (1.f / DM) + EPS);
    if (rstd_out && lane == 0) { rstd_out[0] = r0; rstd_out[1] = r1; }
    u32x2* o8 = (u32x2*)orow + lane;
#pragma unroll
    for (int j = 0; j < 8; ++j) { const float sc = normalise ? (j < 4 ? r0 : r1) : 1.f; u32x2 w; w.x = pk2(v[j].x * sc, v[j].y * sc); w.y = pk2(v[j].z * sc, v[j].w * sc); o8[64 * j] = w; }
}

__device__ __forceinline__ void phase_prep(Frame& F, int l, const float* xsrc, bool do_mem, int kvmask) {
    LAS float* scr = (LAS float*)(F.lds + F.wave * 16384);
    const int gw = F.vcu * NWAVES + F.wave, NGW = F.G * NWAVES, lane = F.lane;
    unsigned char* ws = F.ws;
    const float* g_mix = inptr(F, I_NORM_MIX_G) + l * DM; const float* g_x = inptr(F, I_NORM_X_G) + l * DM; const float* g_ffn = inptr(F, I_NORM_FFN_G) + l * DM;
    constexpr int N_WIN = 16 * 192, N_WA = 8 * 32, N_WP = 2 * 32, N_WC = 8 * 32, N_SQ = 16 * 32, N_GU = 16 * 16, N_D = 4 * 32;
    constexpr int N_FIXED = N_WIN + N_WA + N_WP + N_WC + 3 * N_SQ + 16 * N_GU + 16 * N_D;
    const int n_kv = 2 * N_SQ;
    const int total = N_FIXED + ((kvmask & 1) ? n_kv : 0) + ((kvmask & 2) ? n_kv : 0);
    for (int it = gw; it < total; it += NGW) {
        int r = it;
        if (r < N_WIN) { MapWin mp{inptr(F, I_W_IN) + (size_t)l * DM * 6144}; prep_item(mp, g_mix, (bf16_t*)(ws + WS_WIN_T), 1024, 64 * (r / 192), 32 * (r % 192), scr, lane); continue; } r -= N_WIN;
        if (r < N_WA) { MapPlain mp{inptr(F, I_W_A_OUT) + (size_t)l * 512 * DM, DM, 0}; prep_item(mp, nullptr, (bf16_t*)(ws + WS_WA_T), 512, 64 * (r / 32), 32 * (r % 32), scr, lane); continue; } r -= N_WA;
        if (r < N_WP) { MapPool mp{inptr(F, I_W_POOL) + (size_t)l * 4 * 128 * 256, inptr(F, I_POOL_SCALE) + l * DM}; prep_item(mp, nullptr, (bf16_t*)(ws + WS_WP_T), 512, 64 * (r / 32), 32 * (r % 32), scr, lane); continue; } r -= N_WP;
        if (r < N_WC) { MapPlain mp{inptr(F, I_W_C_OUT) + (size_t)l * 512 * DM, DM, 0}; prep_item(mp, nullptr, (bf16_t*)(ws + WS_WC_T), 512, 64 * (r / 32), 32 * (r % 32), scr, lane); continue; } r -= N_WC;
        if (r < N_SQ) { MapPlain mp{inptr(F, I_W_O) + (size_t)l * DM * DM, DM, 0}; prep_item(mp, nullptr, (bf16_t*)(ws + WS_WO_T), 1024, 64 * (r / 32), 32 * (r % 32), scr, lane); continue; } r -= N_SQ;
        if (r < N_SQ) { MapPlain mp{inptr(F, I_W_XQ) + (size_t)l * DM * DM, DM, 0}; prep_item(mp, g_x, (bf16_t*)(ws + WS_WQ_T), 1024, 64 * (r / 32), 32 * (r % 32), scr, lane); continue; } r -= N_SQ;
        if (r < N_SQ) { MapPlain mp{inptr(F, I_W_XO) + (size_t)l * DM * DM, DM, 0}; prep_item(mp, nullptr, (bf16_t*)(ws + WS_WXO_T), 1024, 64 * (r / 32), 32 * (r % 32), scr, lane); continue; } r -= N_SQ;
        if (r < 16 * N_GU) { const int e = r / N_GU, q = r % N_GU; const size_t eo = ((size_t)l * 16 + e) * DM * 256;
            const float* wg_ = inptr(F, I_W_E_GATE); MapGU mp{wg_ + eo, (long)(inptr(F, I_W_E_UP) - wg_)}; prep_item(mp, g_ffn, (bf16_t*)(ws + WS_WGU_T) + (size_t)e * 512 * 1024, 1024, 64 * (q / 16), 32 * (q % 16), scr, lane); continue; } r -= 16 * N_GU;
        if (r < 16 * N_D) { const int e = r / N_D, q = r % N_D; const size_t eo = ((size_t)l * 16 + e) * 256 * DM;
            MapPlain mp{inptr(F, I_W_E_DOWN) + eo, DM, 0}; prep_item(mp, nullptr, (bf16_t*)(ws + WS_WD_T) + (size_t)e * 1024 * 256, 256, 64 * (q / 32), 32 * (q % 32), scr, lane); continue; } r -= 16 * N_D;
        int kl = 0; if ((kvmask & 1) && r >= n_kv) { r -= n_kv; kl = 1; } else if (!(kvmask & 1)) kl = 1;
        const float* wkv = inptr(F, I_W_XKV) + (size_t)kl * DM * 2048; const float* g_mem = inptr(F, I_NORM_MEM_G) + kl * DM;
        bf16_t* dst = (bf16_t*)(ws + WS_WKV_T) + (size_t)kl * 2 * DM * DM;
        if (r < N_SQ) { MapPlain mp{wkv, 2048, 0}; prep_item(mp, g_mem, dst, 1024, 64 * (r / 32), 32 * (r % 32), scr, lane); }
        else { r -= N_SQ; MapNatural mp{wkv, 2048, 1024}; prep_item(mp, g_mem, dst + (size_t)DM * DM, 1024, 64 * (r / 32), 32 * (r % 32), scr, lane); }
    }
    for (int i = gw * 64 + lane; i < 20 * DM; i += NGW * 64) { const int j = i / DM, k = i % DM;
        const float w = (j < 4) ? inptr(F, I_W_RG)[(size_t)l * DM * 4 + k * 4 + j] : inptr(F, I_W_RE)[(size_t)l * DM * 16 + k * 16 + (j - 4)];
        ((float*)(ws + WS_WR))[i] = w * g_ffn[k]; }
    if (xsrc) for (int m = 2 * gw; m < NTOK; m += 2 * NGW) row2_rstd_bf16(xsrc + (size_t)m * DM, (bf16_t*)(ws + WS_XB) + (size_t)m * DM, (float*)(ws + WS_RSTD_MIX) + m, false, lane);
    if (do_mem) for (int m = 2 * gw; m < 2048; m += 2 * NGW) row2_rstd_bf16(inptr(F, I_MEM) + (size_t)m * DM, (bf16_t*)(ws + WS_MEMB) + (size_t)m * DM, nullptr, true, lane);
}

struct SchedGrid {
    const unsigned char* ws; unsigned A, B; unsigned lda, ldb; int nM, nN, nt, G, c;
    __device__ __forceinline__ bool next(int i, g8::Unit& u) const {
        int pm, pn; if (!g8::static_tile(nM, nN, G, c, i, pm, pn)) return false;
        u.A = A + (unsigned)pm * 256u * lda; u.B = B + (unsigned)pn * 256u * ldb; u.nt = nt; u.pm = pm; u.pn = pn; u.kind = 0; return true;
    }
};

struct EpiResid {
    bf16_t* XB; float* part;
    __device__ __forceinline__ void operator()(f32x4 (&acc)[2][2][4][2], const g8::Unit& u, int wr, int wc, int fr, int fq) const {
#pragma unroll
        for (int ai = 0; ai < 2; ++ai)
#pragma unroll
            for (int m = 0; m < 4; ++m) {
                const int row = u.pm * 256 + ai * 128 + wr * 64 + m * 16 + fr; float ss = 0.f;
#pragma unroll
                for (int bj = 0; bj < 2; ++bj) {
                    bf16_t* xp = XB + (size_t)row * DM + u.pn * 256 + bj * 128 + wc * 32 + 8 * fq;
                    const u32x4 o = *(const u32x4*)xp;
                    f32x4 x0 = acc[ai][bj][m][0], x1 = acc[ai][bj][m][1];
                    x0[0] += bf_lo(o.x); x0[1] += bf_hi(o.x); x0[2] += bf_lo(o.y); x0[3] += bf_hi(o.y); x1[0] += bf_lo(o.z); x1[1] += bf_hi(o.z); x1[2] += bf_lo(o.w); x1[3] += bf_hi(o.w);
                    u32x4 w; w.x = pk2(x0[0], x0[1]); w.y = pk2(x0[2], x0[3]); w.z = pk2(x1[0], x1[1]); w.w = pk2(x1[2], x1[3]); *(u32x4*)xp = w;
                    ss += (x0[0] * x0[0] + x0[1] * x0[1]) + (x0[2] * x0[2] + x0[3] * x0[3]) + (x1[0] * x1[0] + x1[1] * x1[1]) + (x1[2] * x1[2] + x1[3] * x1[3]);
                }
                if (part) { ss += __shfl_xor(ss, 16); ss += __shfl_xor(ss, 32); if (fq == 0) part[(size_t)row * 16 + u.pn * 4 + wc] = ss; }
            }
    }
};

struct EpiInProj {
    const float* rstd; bf16_t *Abuf, *Ubuf, *CXC, *CB, *G01, *G2;
    __device__ __forceinline__ void operator()(f32x4 (&acc)[2][2][4][2], const g8::Unit& u, int wr, int wc, int fr, int fq) const {
        const int pn = u.pn;
#pragma unroll
        for (int ai = 0; ai < 2; ++ai)
#pragma unroll
            for (int m = 0; m < 4; ++m) {
                const int row = u.pm * 256 + ai * 128 + wr * 64 + m * 16 + fr; const float s = rstd[row];
#pragma unroll
                for (int bj = 0; bj < 2; ++bj) {
                    const f32x4 v0 = acc[ai][bj][m][0] * s, v1 = acc[ai][bj][m][1] * s;
                    const int c8 = bj * 128 + wc * 32 + 8 * fq;
                    if (pn < 4 || (pn >= 6 && pn < 10)) {
                        f32x4 r;
                        if (pn < 4) { r[0] = v0[0] * sigm(v1[0]); r[1] = v0[1] * sigm(v1[1]); r[2] = v0[2] * sigm(v1[2]); r[3] = v0[3] * sigm(v1[3]); }
                        else r = v0 * v1;
                        bf16_t* dst = (pn < 4) ? Abuf + (size_t)row * 512 + 128 * pn + (c8 >> 1) : CXC + (size_t)row * 512 + 128 * (pn - 6) + (c8 >> 1);
                        u32x2 w; w.x = pk2(r[0], r[1]); w.y = pk2(r[2], r[3]); *(u32x2*)dst = w;
                    } else {
                        f32x4 a = v0, b = v1; bf16_t* dst;
                        if (pn < 6) dst = Ubuf + (size_t)row * 512 + 256 * (pn - 4) + c8;
                        else if (pn < 12) dst = CB + (size_t)row * 512 + 256 * (pn - 10) + c8;
                        else { dst = (pn < 20) ? G01 + (size_t)row * 2048 + 256 * (pn - 12) + c8 : G2 + (size_t)row * 1024 + 256 * (pn - 20) + c8;
                            a[0] = sigm(a[0]); a[1] = sigm(a[1]); a[2] = sigm(a[2]); a[3] = sigm(a[3]); b[0] = sigm(b[0]); b[1] = sigm(b[1]); b[2] = sigm(b[2]); b[3] = sigm(b[3]); }
                        u32x4 w; w.x = pk2(a[0], a[1]); w.y = pk2(a[2], a[3]); w.z = pk2(b[0], b[1]); w.w = pk2(b[2], b[3]); *(u32x4*)dst = w;
                    }
                }
            }
    }
};

struct SchedMerge {
    const unsigned char* ws; unsigned Aact, Pin, Cact, Wa, Wp, Wc; unsigned lda, ldb; int G, c;
    __device__ __forceinline__ bool next(int i, g8::Unit& u) const {
        const int round = i / 3, kind = i - 3 * round; int pm, pn; if (!g8::static_tile(64, 4, G, c, round, pm, pn)) return false;
        const unsigned ao = (unsigned)pm * 256u * 1024u, bo = (unsigned)pn * 256u * 1024u;
        if (kind == 0) { u.A = Aact + ao; u.B = Wa + bo; u.nt = 8; }
        else if (kind == 1) { u.A = Pin + ao + (unsigned)pn * 256u; u.B = Wp + bo; u.nt = 2; }
        else { u.A = Cact + ao; u.B = Wc + bo; u.nt = 8; }
        u.pm = pm; u.pn = pn; u.kind = kind; return true;
    }
};
struct EpiMerge {
    const bf16_t* G01; const bf16_t* G2; bf16_t* M;
    __device__ __forceinline__ void operator()(f32x4 (&acc)[2][2][4][2], const g8::Unit& u, int wr, int wc, int fr, int fq) const {
        const int kind = u.kind;
#pragma unroll
        for (int ai = 0; ai < 2; ++ai)
#pragma unroll
            for (int m = 0; m < 4; ++m) {
                const int row = u.pm * 256 + ai * 128 + wr * 64 + m * 16 + fr;
#pragma unroll
                for (int bj = 0; bj < 2; ++bj) {
                    const int col = u.pn * 256 + bj * 128 + wc * 32 + 8 * fq;
                    const u32x4 g = *(const u32x4*)((kind < 2) ? G01 + (size_t)row * 2048 + kind * 1024 + col : G2 + (size_t)row * 1024 + col);
                    f32x4 r0, r1;
                    r0[0] = bf_lo(g.x) * acc[ai][bj][m][0][0]; r0[1] = bf_hi(g.x) * acc[ai][bj][m][0][1]; r0[2] = bf_lo(g.y) * acc[ai][bj][m][0][2]; r0[3] = bf_hi(g.y) * acc[ai][bj][m][0][3];
                    r1[0] = bf_lo(g.z) * acc[ai][bj][m][1][0]; r1[1] = bf_hi(g.z) * acc[ai][bj][m][1][1]; r1[2] = bf_lo(g.w) * acc[ai][bj][m][1][2]; r1[3] = bf_hi(g.w) * acc[ai][bj][m][1][3];
                    bf16_t* mp = M + (size_t)row * 1024 + col;
                    if (kind != 0) { const u32x4 o = *(const u32x4*)mp;
                        r0[0] += bf_lo(o.x); r0[1] += bf_hi(o.x); r0[2] += bf_lo(o.y); r0[3] += bf_hi(o.y); r1[0] += bf_lo(o.z); r1[1] += bf_hi(o.z); r1[2] += bf_lo(o.w); r1[3] += bf_hi(o.w); }
                    u32x4 w; w.x = pk2(r0[0], r0[1]); w.y = pk2(r0[2], r0[3]); w.z = pk2(r1[0], r1[1]); w.w = pk2(r1[2], r1[3]); *(u32x4*)mp = w;
                }
            }
    }
};

#define OPQ(p) asm volatile("" : "+v"(p))
template <int W> __device__ __forceinline__ void pool_half(const bf16_t* U, bf16_t* P, int t0, int c) {
    float f0[31 + W], f1[31 + W];
    const bf16_t* up = U + (ptrdiff_t)(t0 - W + 1) * 512 + c;
#pragma unroll
    for (int i = 0; i < 31 + W; ++i) { const unsigned w = *(const unsigned*)up; up += 512; OPQ(up); const bool z = (t0 - W + 1 + i) < 0; f0[i] = z ? 0.f : bf_lo(w); f1[i] = z ? 0.f : bf_hi(w); }
    float s0 = 0.f, s1 = 0.f;
#pragma unroll
    for (int i = 0; i < W - 1; ++i) { s0 += f0[i]; s1 += f1[i]; }
    bf16_t* pp = P + (size_t)t0 * 512 + c;
#pragma unroll
    for (int tt = 0; tt < 32; ++tt) {
        s0 += f0[tt + W - 1]; s1 += f1[tt + W - 1];
        const int t = t0 + tt; const float inv = 1.f / (float)((t + 1 < W) ? (t + 1) : W);
        *(unsigned*)pp = pk2(s0 * inv - f0[tt + W - 1], s1 * inv - f1[tt + W - 1]); pp += 512; OPQ(pp);
        s0 -= f0[tt]; s1 -= f1[tt];
    }
}
__device__ __forceinline__ void phase_p2(Frame& F, int l) {
    const int tid = F.tid, half = __builtin_amdgcn_readfirstlane(tid >> 8), c = 2 * (tid & 255), lane = F.lane, wave = F.wave;
    unsigned char* ws = F.ws;
    const bf16_t* Abuf = (const bf16_t*)(ws + WS_ABUF); const bf16_t* Ubuf = (const bf16_t*)(ws + WS_UBUF); const bf16_t* CXC = (const bf16_t*)(ws + WS_CXC); bf16_t* CB = (bf16_t*)(ws + WS_CB);
    bf16_t* Aact = (bf16_t*)(ws + WS_AACT); bf16_t* Pin = (bf16_t*)(ws + WS_PIN);
    const float* cw = inptr(F, I_CONV_A_W) + l * 31 * 512; const float* cb = inptr(F, I_CONV_A_B) + l * 512;
    const float* lg = inptr(F, I_LN_A_G) + l * 512; const float* lb = inptr(F, I_LN_A_B) + l * 512; const float* ccw = inptr(F, I_CONV_C_W) + l * 3 * 512;
    LAS float* V = (LAS float*)F.lds;
    for (int seg = blockIdx.x; seg < NTOK / 64; seg += F.G) {
        const int b = seg >> 5, ts = (seg & 31) * 64;
        const size_t seq0 = (size_t)b * SEQ;
        const int t0 = ts + 32 * half;
        {
            const int ch = tid;
            float w[31];
#pragma unroll
            for (int k = 0; k < 31; ++k) w[k] = cw[k * 512 + ch];
            const float bias = cb[ch];
#pragma unroll 1
            for (int hp = 0; hp < 2; ++hp) {
                const int tb = ts + 32 * hp;
                float x[62];
                const bf16_t* src = Abuf + ((ptrdiff_t)seq0 + tb - 30) * 512 + ch;
#pragma unroll
                for (int i = 0; i < 62; ++i) { const unsigned short hv = *src; src += 512; OPQ(src); x[i] = (tb - 30 + i < 0) ? 0.f : __uint_as_float((unsigned)hv << 16); }
                LAS float* vp = V + (32 * hp) * 512 + ch;
#pragma unroll
                for (int o = 0; o < 32; ++o) {
                    float a0 = bias;
#pragma unroll
                    for (int k = 0; k < 31; ++k) a0 += w[k] * x[o + k];
                    vp[o * 512] = a0;
                }
            }
        }
        {
            const bf16_t* U = Ubuf + seq0 * 512; bf16_t* P = Pin + seq0 * 512; const int g = __builtin_amdgcn_readfirstlane((tid & 255) >> 6);
            if (g == 0) pool_half<2>(U, P, t0, c); else if (g == 1) pool_half<4>(U, P, t0, c); else if (g == 2) pool_half<8>(U, P, t0, c); else pool_half<16>(U, P, t0, c);
        }
        {
            const f32x2 k0 = *(const f32x2*)(ccw + c), k1 = *(const f32x2*)(ccw + 512 + c), k2 = *(const f32x2*)(ccw + 1024 + c);
            const bf16_t* xp = CXC + ((ptrdiff_t)seq0 + t0 - 2) * 512 + c; bf16_t* Bp = CB + (seq0 + t0) * 512 + c; const bf16_t* bp = Bp;
            unsigned xv[34], bv[32];
#pragma unroll
            for (int i = 0; i < 34; ++i) { const unsigned wv = *(const unsigned*)xp; xp += 512; OPQ(xp); xv[i] = (t0 - 2 + i < 0) ? 0u : wv; }
#pragma unroll
            for (int i = 0; i < 32; ++i) { bv[i] = *(const unsigned*)bp; bp += 512; OPQ(bp); }
#pragma unroll
            for (int tt = 0; tt < 32; ++tt) {
                const float v0 = k0.x * bf_lo(xv[tt]) + k1.x * bf_lo(xv[tt + 1]) + k2.x * bf_lo(xv[tt + 2]), v1 = k0.y * bf_hi(xv[tt]) + k1.y * bf_hi(xv[tt + 1]) + k2.y * bf_hi(xv[tt + 2]);
                *(unsigned*)Bp = pk2(bf_lo(bv[tt]) * v0, bf_hi(bv[tt]) * v1); Bp += 512; OPQ(Bp);
            }
        }
        __syncthreads();
        {
            const f32x4 g0 = *(const f32x4*)(lg + 8 * lane), g1 = *(const f32x4*)(lg + 8 * lane + 4), b0 = *(const f32x4*)(lb + 8 * lane), b1 = *(const f32x4*)(lb + 8 * lane + 4);
            for (int i = 0; i < 8; ++i) {
                const int tok = wave * 8 + i;
                const f32x4 v0 = *(const LAS f32x4*)(V + tok * 512 + 8 * lane), v1 = *(const LAS f32x4*)(V + tok * 512 + 8 * lane + 4);
                const float mu = wave_sum((v0[0] + v0[1]) + (v0[2] + v0[3]) + (v1[0] + v1[1]) + (v1[2] + v1[3])) * (1.f / 512.f);
                const f32x4 d0 = v0 - mu, d1 = v1 - mu;
                const float var = wave_sum((d0[0] * d0[0] + d0[1] * d0[1]) + (d0[2] * d0[2] + d0[3] * d0[3]) + (d1[0] * d1[0] + d1[1] * d1[1]) + (d1[2] * d1[2] + d1[3] * d1[3])) * (1.f / 512.f);
                const float rs = rsqrtf(var + EPS);
                f32x4 y0 = d0 * rs * g0 + b0, y1 = d1 * rs * g1 + b1;
                y0[0] *= sigm(y0[0]); y0[1] *= sigm(y0[1]); y0[2] *= sigm(y0[2]); y0[3] *= sigm(y0[3]); y1[0] *= sigm(y1[0]); y1[1] *= sigm(y1[1]); y1[2] *= sigm(y1[2]); y1[3] *= sigm(y1[3]);
                u32x4 w; w.x = pk2(y0[0], y0[1]); w.y = pk2(y0[2], y0[3]); w.z = pk2(y1[0], y1[1]); w.w = pk2(y1[2], y1[3]);
                *(u32x4*)(Aact + (seq0 + ts + tok) * 512 + 8 * lane) = w;
            }
        }
        __syncthreads();
    }
}


struct SchedKV {
    const unsigned char* ws; unsigned memb, wkv; unsigned lda, ldb; int mask, G, c;
    __device__ __forceinline__ bool next(int i, g8::Unit& u) const {
        int L = i * G + c; const int nl = ((mask & 1) ? 1 : 0) + ((mask & 2) ? 1 : 0); if (L >= 64 * nl) return false;
        int kl = (mask & 1) ? 0 : 1; if (L >= 64) { L -= 64; kl = 1; }
        const unsigned w = wkv + (unsigned)kl * 2u * 1024u * 2048u;
        if (L < 32) { u.pm = L >> 2; u.pn = L & 3; u.A = memb + (unsigned)u.pm * 256u * 2048u; u.B = w + (unsigned)u.pn * 256u * 2048u; u.kind = 2 * kl; }
        else { L -= 32; u.pm = L >> 3; u.pn = L & 7; u.A = w + 1024u * 2048u + (unsigned)u.pm * 256u * 2048u; u.B = memb + (unsigned)u.pn * 256u * 2048u; u.kind = 2 * kl + 1; }
        u.nt = 16; return true;
    }
};
struct EpiKV {
    bf16_t* KV;
    __device__ __forceinline__ void operator()(f32x4 (&acc)[2][2][4][2], const g8::Unit& u, int wr, int wc, int fr, int fq) const {
        bf16_t* base = KV + (size_t)(u.kind >> 1) * 4 * 1024 * 1024;
        const int sfq = (fq == 1) ? 2 : (fq == 2 ? 1 : fq);
#pragma unroll
        for (int ai = 0; ai < 2; ++ai)
#pragma unroll
            for (int m = 0; m < 4; ++m) {
                const int row = u.pm * 256 + ai * 128 + wr * 64 + m * 16 + fr;
#pragma unroll
                for (int bj = 0; bj < 2; ++bj) {
                    if ((u.kind & 1) == 0) {
                        const f32x4 a = acc[ai][bj][m][0], b = acc[ai][bj][m][1];
                        u32x4 w; w.x = pk2(a[0], a[1]); w.y = pk2(a[2], a[3]); w.z = pk2(b[0], b[1]); w.w = pk2(b[2], b[3]);
                        *(u32x4*)(base + (size_t)row * 1024 + u.pn * 256 + bj * 128 + wc * 32 + 8 * fq) = w;
                    } else {
#pragma unroll
                        for (int n = 0; n < 2; ++n) { const f32x4 a = acc[ai][bj][m][n]; u32x2 w; w.x = pk2(a[0], a[1]); w.y = pk2(a[2], a[3]);
                            *(u32x2*)(base + (size_t)2048 * 1024 + ((size_t)u.pn * 1024 + row) * 256 + bj * 128 + wc * 32 + 16 * n + 4 * sfq) = w; }
                    }
                }
            }
    }
};
struct EpiQ {
    const float* part; bf16_t* Q;
    __device__ __forceinline__ void operator()(f32x4 (&acc)[2][2][4][2], const g8::Unit& u, int wr, int wc, int fr, int fq) const {
#pragma unroll
        for (int ai = 0; ai < 2; ++ai)
#pragma unroll
            for (int m = 0; m < 4; ++m) {
                const int row = u.pm * 256 + ai * 128 + wr * 64 + m * 16 + fr;
                const f32x4 pv = *(const f32x4*)(part + (size_t)row * 16 + 4 * fq);
                float ss = (pv[0] + pv[1]) + (pv[2] + pv[3]); ss += __shfl_xor(ss, 16); ss += __shfl_xor(ss, 32);
                const float s = rsqrtf(ss * (1.f / DM) + EPS) * (0.0625f * 1.4426950408889634f);
#pragma unroll
                for (int bj = 0; bj < 2; ++bj) {
                    const f32x4 a = acc[ai][bj][m][0] * s, b = acc[ai][bj][m][1] * s;
                    u32x4 w; w.x = pk2(a[0], a[1]); w.y = pk2(a[2], a[3]); w.z = pk2(b[0], b[1]); w.w = pk2(b[2], b[3]);
                    *(u32x4*)(Q + (size_t)row * 1024 + u.pn * 256 + bj * 128 + wc * 32 + 8 * fq) = w;
                }
            }
    }
};
constexpr int ATT_ROWB = 528; static_assert(256 * ATT_ROWB <= CTRL_OFF, "attention tile image must stay below the LDS control area");
__device__ __forceinline__ void att_fill(LAS unsigned char* lds, const bf16_t* src, size_t row_stride_el, int tid) {
    const bf16_t* gp = src + (size_t)(tid >> 5) * row_stride_el + (tid & 31) * 8;
    LAS unsigned char* lp = lds + (tid >> 5) * ATT_ROWB + (tid & 31) * 16;
#pragma unroll
    for (int p0 = 0; p0 < 16; p0 += 4) {
        u32x4 v[4];
#pragma unroll
        for (int j = 0; j < 4; ++j) { v[j] = *(const u32x4*)gp; gp += 16 * row_stride_el; asm volatile("" : "+v"(gp)); }
#pragma unroll
        for (int j = 0; j < 4; ++j) { *(LAS u32x4*)lp = v[j]; lp += 16 * ATT_ROWB; asm volatile("" : "+v"(lp)); }
    }
}
__device__ __forceinline__ void phase_attn(Frame& F, int l) {
    const int tid = F.tid, lane = F.lane, wave = F.wave, r = lane & 31, hh = lane >> 5;
    const bf16_t* Q = (const bf16_t*)(F.ws + WS_Q); bf16_t* O = (bf16_t*)(F.ws + WS_O);
    const bf16_t* Kb = (const bf16_t*)(F.ws + WS_KV) + (size_t)l * 4 * 1024 * 1024; const bf16_t* Vt = Kb + (size_t)2048 * 1024;
    for (int id = blockIdx.x; id < 256; id += F.G) {
        const int xcd = id & 7, j = id >> 3, pair = xcd * 4 + (j >> 3), qb = j & 7, b = pair >> 2, h = pair & 3;
        const size_t qrow = (size_t)b * SEQ + qb * 256 + wave * 32 + r;
        att_fill(F.lds, Kb + (size_t)b * 256 * 1024 + h * 256, 1024, tid);
        __syncthreads();
        f32x16 acc[8];
        const LAS unsigned char* frag = F.lds + r * ATT_ROWB + hh * 16;
#pragma unroll
        for (int kb = 0; kb < 8; ++kb)
#pragma unroll
            for (int i = 0; i < 16; ++i) acc[kb][i] = 0.f;
        const bf16_t* qp = Q + qrow * 1024 + h * 256 + 8 * hh;
        bf16x8 qn = *(const bf16x8*)qp;
#pragma unroll 1
        for (int s = 0; s < 16; ++s) {
            const bf16x8 q = qn; if (s < 15) qn = *(const bf16x8*)(qp + 16 * (s + 1));
#pragma unroll
            for (int kb = 0; kb < 8; ++kb) { const bf16x8 a = *(const LAS bf16x8*)(frag + kb * 32 * ATT_ROWB + s * 32); acc[kb] = __builtin_amdgcn_mfma_f32_32x32x16_bf16(a, q, acc[kb], 0, 0, 0); }
        }
        float mx = acc[0][0];
#pragma unroll
        for (int kb = 0; kb < 8; ++kb)
#pragma unroll
            for (int i = 0; i < 16; ++i) mx = fmaxf(mx, acc[kb][i]);
        mx = fmaxf(mx, __shfl_xor(mx, 32));
        float sum = 0.f;
#pragma unroll
        for (int kb = 0; kb < 8; ++kb)
#pragma unroll
            for (int i = 0; i < 16; ++i) { const float p = __builtin_amdgcn_exp2f(acc[kb][i] - mx); acc[kb][i] = p; sum += p; }
        sum += __shfl_xor(sum, 32);
        const float inv = 1.f / sum;
        bf16x8 pf[16];
#pragma unroll
        for (int kb = 0; kb < 8; ++kb)
#pragma unroll
            for (int s2 = 0; s2 < 2; ++s2) { u32x4 w; w.x = pk2(acc[kb][8 * s2 + 0], acc[kb][8 * s2 + 1]); w.y = pk2(acc[kb][8 * s2 + 2], acc[kb][8 * s2 + 3]);
                w.z = pk2(acc[kb][8 * s2 + 4], acc[kb][8 * s2 + 5]); w.w = pk2(acc[kb][8 * s2 + 6], acc[kb][8 * s2 + 7]); pf[2 * kb + s2] = __builtin_bit_cast(bf16x8, w); }
        __syncthreads();
        att_fill(F.lds, Vt + ((size_t)b * 1024 + h * 256) * 256, 256, tid);
        __syncthreads();
        bf16_t* orow = O + qrow * 1024 + h * 256 + 4 * hh;
#pragma unroll 1
        for (int db = 0; db < 8; ++db) {
            f32x16 o;
#pragma unroll
            for (int i = 0; i < 16; ++i) o[i] = 0.f;
#pragma unroll
            for (int ks = 0; ks < 16; ++ks) { const bf16x8 a = *(const LAS bf16x8*)(frag + db * 32 * ATT_ROWB + ks * 32); o = __builtin_amdgcn_mfma_f32_32x32x16_bf16(a, pf[ks], o, 0, 0, 0); }
#pragma unroll
            for (int g = 0; g < 4; ++g) { u32x2 w; w.x = pk2(o[4 * g] * inv, o[4 * g + 1] * inv); w.y = pk2(o[4 * g + 2] * inv, o[4 * g + 3] * inv); *(u32x2*)(orow + 32 * db + 8 * g) = w; }
        }
        __syncthreads();
    }
}


constexpr int ECAP = 16384;
constexpr int MW_TP = 16, MW_CNT = 40, MW_TE = 64;
__device__ __forceinline__ void moe_table(Frame& F, int l) {
    if (F.tid < 16) F.MISC[MW_CNT + F.tid] = __hip_atomic_load(F.ctl + CW_ECNT + l * 64 + F.tid, __ATOMIC_RELAXED, __HIP_MEMORY_SCOPE_AGENT);
    __syncthreads();
    if (F.tid == 0) { unsigned a = 0; for (int e = 0; e < 16; ++e) { F.MISC[MW_TP + e] = a; const unsigned nt_ = (F.MISC[MW_CNT + e] + 255u) >> 8; for (unsigned k = 0; k < nt_ && a + k < 144u; ++k) F.MISC[MW_TE + a + k] = (unsigned)e; a += nt_; } F.MISC[MW_TP + 16] = a; }
    __syncthreads();
}
__device__ __forceinline__ int misc_u(volatile LAS unsigned* M, int i) { return __builtin_amdgcn_readfirstlane((int)M[i]); }
__device__ __forceinline__ int moe_expert_of_tile(volatile LAS unsigned* M, int ti) { return misc_u(M, MW_TE + ti); }

__device__ __forceinline__ void route_one(const float (&L)[20], const float (&bias)[20], float rstd, int& eg1, int& eg2, float& w1, float& w2) {
    float lg[4]; int gi = 0; float mg;
#pragma unroll
    for (int j = 0; j < 4; ++j) lg[j] = L[j] * rstd + bias[j];
    mg = lg[0];
#pragma unroll
    for (int j = 1; j < 4; ++j) if (lg[j] > mg) { mg = lg[j]; gi = j; }
    float se = 0.f;
#pragma unroll
    for (int j = 0; j < 4; ++j) se += __expf(lg[j] - mg);
    const float gval = 1.f / se;
    float le[4];
#pragma unroll
    for (int j = 0; j < 4; ++j) { const float a = L[4 + j] * rstd + bias[4 + j], b = L[8 + j] * rstd + bias[8 + j], c = L[12 + j] * rstd + bias[12 + j], d = L[16 + j] * rstd + bias[16 + j];
        le[j] = (gi == 0) ? a : (gi == 1) ? b : (gi == 2) ? c : d; }
    int e1 = 0; float m1 = le[0];
#pragma unroll
    for (int j = 1; j < 4; ++j) if (le[j] > m1) { m1 = le[j]; e1 = j; }
    int e2 = -1; float m2 = -3.0e38f;
#pragma unroll
    for (int j = 0; j < 4; ++j) if (j != e1 && le[j] > m2) { m2 = le[j]; e2 = j; }
    const float p2 = __expf(m2 - m1);
    w1 = gval / (1.f + p2); w2 = gval * p2 / (1.f + p2); eg1 = gi * 4 + e1; eg2 = gi * 4 + e2;
}
__device__ __forceinline__ void phase_router(Frame& F, int l) {
    const int tid = F.tid, lane = F.lane, wave = F.wave, ks = lane & 7, tsub = lane >> 3;
    LAS float* WR = (LAS float*)F.lds;
    LAS unsigned* lcnt = (LAS unsigned*)(F.lds + 81920);
    LAS unsigned* ent = lcnt + 64;
    LAS float* entw = (LAS float*)(ent + 128);
    LAS float* lrstd = entw + 128;
    for (int i = tid; i < 20 * DM / 4; i += NTHREADS) ((LAS f32x4*)WR)[i] = ((const f32x4*)(F.ws + WS_WR))[i];
    unsigned* gcnt = F.ctl + CW_ECNT + l * 64;
    int* ROWTOK = (int*)(F.ws + WS_ROWTOK); float* ROWW = (float*)(F.ws + WS_ROWW); float* ROWRSTD = (float*)(F.ws + WS_ROWRSTD); unsigned* TOKSLOT = (unsigned*)(F.ws + WS_TOKSLOT);
    for (int chunk = blockIdx.x; chunk < NTOK / 64; chunk += F.G) {
        if (tid < 16) lcnt[tid] = 0u;
        __syncthreads();
        const int tl = wave * 8 + tsub; const size_t tok = (size_t)chunk * 64 + tl;
        const u32x4* xr = (const u32x4*)((const bf16_t*)(F.ws + WS_XB) + tok * DM) + ks;
        float L[20]; float ss = 0.f;
#pragma unroll
        for (int j = 0; j < 20; ++j) L[j] = 0.f;
#pragma unroll 1
        for (int i0 = 0; i0 < 16; i0 += 2) {
            const u32x4 q0 = xr[8 * i0], q1 = xr[8 * i0 + 8];
            f32x4 xv[4];
            xv[0] = (f32x4){bf_lo(q0.x), bf_hi(q0.x), bf_lo(q0.y), bf_hi(q0.y)}; xv[1] = (f32x4){bf_lo(q0.z), bf_hi(q0.z), bf_lo(q0.w), bf_hi(q0.w)};
            xv[2] = (f32x4){bf_lo(q1.x), bf_hi(q1.x), bf_lo(q1.y), bf_hi(q1.y)}; xv[3] = (f32x4){bf_lo(q1.z), bf_hi(q1.z), bf_lo(q1.w), bf_hi(q1.w)};
#pragma unroll
            for (int i = 0; i < 4; ++i) ss += (xv[i][0] * xv[i][0] + xv[i][1] * xv[i][1]) + (xv[i][2] * xv[i][2] + xv[i][3] * xv[i][3]);
            const LAS float* wp = WR + 8 * (ks + 8 * i0);
#pragma unroll
            for (int j = 0; j < 20; ++j) {
#pragma unroll
                for (int i = 0; i < 4; ++i) { const f32x4 w = *(const LAS f32x4*)(wp + j * 1024 + 64 * (i >> 1) + 4 * (i & 1)); L[j] += (xv[i][0] * w[0] + xv[i][1] * w[1]) + (xv[i][2] * w[2] + xv[i][3] * w[3]); }
            }
        }
#pragma unroll
        for (int o = 1; o < 8; o <<= 1) { ss += __shfl_xor(ss, o);
#pragma unroll
            for (int j = 0; j < 20; ++j) L[j] += __shfl_xor(L[j], o); }
        const float rs = rsqrtf(ss * (1.f / DM) + EPS);
        float bias[20];
        { const float* brg = inptr(F, I_B_RG) + l * 4; const float* bre = inptr(F, I_B_RE) + l * 16;
#pragma unroll
      for (int j = 0; j < 4; ++j) bias[j] = brg[j];
#pragma unroll
      for (int j = 0; j < 16; ++j) bias[4 + j] = bre[j]; }
        int e1, e2; float w1, w2;
        route_one(L, bias, rs, e1, e2, w1, w2);
        if (ks == 0) {
            unsigned p;
            p = __hip_atomic_fetch_add(lcnt + e1, 1u, __ATOMIC_RELAXED, __HIP_MEMORY_SCOPE_WORKGROUP); ent[tl * 2 + 0] = ((unsigned)e1 << 16) | p; entw[tl * 2 + 0] = w1;
            p = __hip_atomic_fetch_add(lcnt + e2, 1u, __ATOMIC_RELAXED, __HIP_MEMORY_SCOPE_WORKGROUP); ent[tl * 2 + 1] = ((unsigned)e2 << 16) | p; entw[tl * 2 + 1] = w2;
            lrstd[tl] = rs;
        }
        __syncthreads();
        if (tid < 16) lcnt[16 + tid] = __hip_atomic_fetch_add(gcnt + tid, lcnt[tid], __ATOMIC_RELAXED, __HIP_MEMORY_SCOPE_AGENT);
        __syncthreads();
        if (tid < 128) { const int t2 = tid >> 1; const unsigned en = ent[tid], e = en >> 16, pos = lcnt[16 + e] + (en & 0xffffu); const int token = chunk * 64 + t2;
            ROWTOK[e * ECAP + pos] = token; ROWW[e * ECAP + pos] = entw[tid]; ROWRSTD[e * ECAP + pos] = lrstd[t2]; TOKSLOT[token * 2 + (tid & 1)] = (e << 20) | pos; }
        __syncthreads();
    }
}
struct SchedMoe1 {
    const unsigned char* ws; unsigned XB, W; const int* rowtok; volatile LAS unsigned* M; unsigned lda, ldb; int G, c;
    __device__ __forceinline__ bool next(int i, g8::Unit& u) const {
        const int L = i * G + c; if (L >= 2 * misc_u(M, MW_TP + 16)) return false;
        const int ti = L >> 1, pn = L & 1, e = moe_expert_of_tile(M, ti), mt = ti - misc_u(M, MW_TP + e), ne = misc_u(M, MW_CNT + e);
        u.A = XB; u.B = W + ((unsigned)e * 512u + (unsigned)pn * 256u) * 2048u; u.gth = rowtok + e * ECAP + mt * 256; u.nvalid = ne - mt * 256; u.nt = 16; u.pm = ti; u.pn = pn; u.kind = e * ECAP + mt * 256; return true;
    }
};
struct EpiMoe1 {
    const float* roww; const float* rowrstd; bf16_t* ACT;
    __device__ __forceinline__ void operator()(f32x4 (&acc)[2][2][4][2], const g8::Unit& u, int wr, int wc, int fr, int fq) const {
#pragma unroll
        for (int ai = 0; ai < 2; ++ai)
#pragma unroll
            for (int m = 0; m < 4; ++m) {
                const int rr = ai * 128 + wr * 64 + m * 16 + fr; const float s = rowrstd[u.kind + rr], w = roww[u.kind + rr];
#pragma unroll
                for (int bj = 0; bj < 2; ++bj) {
                    const f32x4 g = acc[ai][bj][m][0] * s, up = acc[ai][bj][m][1] * s; f32x4 r;
                    r[0] = g[0] * sigm(g[0]) * up[0] * w; r[1] = g[1] * sigm(g[1]) * up[1] * w; r[2] = g[2] * sigm(g[2]) * up[2] * w; r[3] = g[3] * sigm(g[3]) * up[3] * w;
                    u32x2 o; o.x = pk2(r[0], r[1]); o.y = pk2(r[2], r[3]);
                    *(u32x2*)(ACT + ((size_t)u.pm * 256 + rr) * 256 + 128 * u.pn + ((bj * 128 + wc * 32 + 8 * fq) >> 1)) = o;
                }
            }
    }
};
struct SchedMoe2 {
    const unsigned char* ws; unsigned ACT, W; volatile LAS unsigned* M; unsigned lda, ldb; int G, c;
    __device__ __forceinline__ bool next(int i, g8::Unit& u) const {
        const int L = i * G + c; if (L >= 4 * misc_u(M, MW_TP + 16)) return false;
        const int ti = L >> 2, pn = L & 3, e = moe_expert_of_tile(M, ti);
        u.A = ACT + (unsigned)ti * 256u * 512u; u.B = W + ((unsigned)e * 1024u + (unsigned)pn * 256u) * 512u; u.nt = 4; u.pm = ti; u.pn = pn; u.kind = 0; return true;
    }
};
struct EpiY {
    bf16_t* Y;
    __device__ __forceinline__ void operator()(f32x4 (&acc)[2][2][4][2], const g8::Unit& u, int wr, int wc, int fr, int fq) const {
#pragma unroll
        for (int ai = 0; ai < 2; ++ai)
#pragma unroll
            for (int m = 0; m < 4; ++m) {
                const size_t row = (size_t)u.pm * 256 + ai * 128 + wr * 64 + m * 16 + fr;
#pragma unroll
                for (int bj = 0; bj < 2; ++bj) { const f32x4 a = acc[ai][bj][m][0], b = acc[ai][bj][m][1];
                    u32x4 w; w.x = pk2(a[0], a[1]); w.y = pk2(a[2], a[3]); w.z = pk2(b[0], b[1]); w.w = pk2(b[2], b[3]);
                    *(u32x4*)(Y + row * 1024 + u.pn * 256 + bj * 128 + wc * 32 + 8 * fq) = w; }
            }
    }
};
__device__ __forceinline__ void phase_combine(Frame& F, float* OUT, bool last) {
    const int gw = F.vcu * NWAVES + F.wave, NGW = F.G * NWAVES, lane = F.lane;
    const unsigned* TOKSLOT = (const unsigned*)(F.ws + WS_TOKSLOT); const bf16_t* Y = (const bf16_t*)(F.ws + WS_Y);
    const float* gf = inptr(F, I_NORM_F_G);
    for (int m = gw; m < NTOK; m += NGW) {
        const unsigned s0 = TOKSLOT[2 * m], s1 = TOKSLOT[2 * m + 1];
        const size_t r0 = (size_t)F.MISC[MW_TP + (s0 >> 20)] * 256 + (s0 & 0xfffffu), r1 = (size_t)F.MISC[MW_TP + (s1 >> 20)] * 256 + (s1 & 0xfffffu);
        u32x4* xr = (u32x4*)((bf16_t*)(F.ws + WS_XB) + (size_t)m * DM) + lane; const u32x4* y0 = (const u32x4*)(Y + r0 * DM) + lane; const u32x4* y1 = (const u32x4*)(Y + r1 * DM) + lane;
        f32x4 v[4]; float ss = 0.f;
#pragma unroll
        for (int j = 0; j < 2; ++j) { const u32x4 a = y0[64 * j], b = y1[64 * j], x = xr[64 * j];
            v[2 * j] = (f32x4){bf_lo(x.x) + bf_lo(a.x) + bf_lo(b.x), bf_hi(x.x) + bf_hi(a.x) + bf_hi(b.x), bf_lo(x.y) + bf_lo(a.y) + bf_lo(b.y), bf_hi(x.y) + bf_hi(a.y) + bf_hi(b.y)};
            v[2 * j + 1] = (f32x4){bf_lo(x.z) + bf_lo(a.z) + bf_lo(b.z), bf_hi(x.z) + bf_hi(a.z) + bf_hi(b.z), bf_lo(x.w) + bf_lo(a.w) + bf_lo(b.w), bf_hi(x.w) + bf_hi(a.w) + bf_hi(b.w)}; }
#pragma unroll
        for (int j = 0; j < 4; ++j) ss += (v[j][0] * v[j][0] + v[j][1] * v[j][1]) + (v[j][2] * v[j][2] + v[j][3] * v[j][3]);
        const float rstd = rsqrtf(wave_sum(ss) * (1.f / DM) + EPS);
        if (last) {
            f32x4* orow = (f32x4*)(OUT + (size_t)m * DM) + 2 * lane;
#pragma unroll
            for (int j = 0; j < 2; ++j) { const f32x4 g0 = *((const f32x4*)gf + 2 * lane + 128 * j), g1 = *((const f32x4*)gf + 2 * lane + 128 * j + 1);
                orow[128 * j] = v[2 * j] * rstd * g0; orow[128 * j + 1] = v[2 * j + 1] * rstd * g1; }
        } else {
            if (lane == 0) ((float*)(F.ws + WS_RSTD_MIX))[m] = rstd;
#pragma unroll
            for (int j = 0; j < 2; ++j) { u32x4 w; w.x = pk2(v[2 * j][0], v[2 * j][1]); w.y = pk2(v[2 * j][2], v[2 * j][3]); w.z = pk2(v[2 * j + 1][0], v[2 * j + 1][1]); w.w = pk2(v[2 * j + 1][2], v[2 * j + 1][3]); xr[64 * j] = w; }
        }
    }
}

enum { PH_PREP = 0, PH_KV, PH_P1, PH_P2, PH_P3, PH_P4, PH_P5, PH_P6, PH_P7, PH_P8, PH_P9, PH_P10, PH_P11, PH_COUNT };

__global__ void __launch_bounds__(NTHREADS, 2) mega(Args args) {
    extern __shared__ __attribute__((aligned(16))) unsigned char lds_raw[];
    Frame F;
    F.lds = (LAS unsigned char*)lds_raw; F.MISC = (volatile LAS unsigned*)(F.lds + MISC_OFF);
    F.tid = threadIdx.x; F.lane = F.tid & 63; F.wave = __builtin_amdgcn_readfirstlane(F.tid >> 6);
    F.G = gridDim.x; { const int bx = blockIdx.x; F.vcu = (F.G % 8 == 0) ? (bx % 8) * (F.G / 8) + bx / 8 : bx; }
    F.ws = args.ws; F.ctl = (unsigned*)(args.ws + WS_CTL);
    for (int u = F.tid; u < (PTAB_OFF - MISC_OFF) / 4; u += NTHREADS) F.MISC[u] = 0u;
    if (F.tid < 28) ((LAS unsigned long long*)(F.lds + PTAB_OFF))[F.tid] = (unsigned long long)args.in[F.tid];
    __syncthreads();
    const bool fused = (args.flags & 8) != 0;
    XcdBarrier bar; bar.bar = F.ctl + CW_BAR; bar.x = 0; bar.st = nullptr;
    if (fused) bar = xcd_barrier_post(F.ctl + CW_BAR, F.MISC + 8);
    const int lo = args.ph_lo, hi = args.ph_hi;
    const int l_lo = fused ? 0 : args.layer, l_hi = fused ? 2 : args.layer + 1;
#define IN(k) (lo <= (k) && (k) < hi)
#ifdef PROBE_MASK
    int n_stamp = 0;
#define STAMP() do { if (blockIdx.x == 0 && F.tid == 0) { const unsigned long long t_ = __builtin_amdgcn_s_memrealtime(); F.MISC[256 + 2 * n_stamp] = (unsigned)t_; F.MISC[257 + 2 * n_stamp] = (unsigned)(t_ >> 32); } ++n_stamp; } while (0)
    STAMP();
#else
#define STAMP() do { } while (0)
#endif
#define SEAM() do { if (fused) xcd_barrier(bar); LAUNDER(); STAMP(); } while (0)
#define LAUNDER() do { unsigned char* w_ = F.ws; asm volatile("" : "+s"(w_)); F.ws = w_; F.ctl = (unsigned*)(w_ + WS_CTL); int t_ = F.tid; asm volatile("" : "+v"(t_)); F.tid = t_; F.lane = t_ & 63; F.wave = __builtin_amdgcn_readfirstlane(t_ >> 6); } while (0)
#pragma unroll
    for (int l = 0; l < 2; ++l) { if (l < l_lo || l >= l_hi) continue;
    if (IN(PH_PREP)) if (!(fused && l == 1)) {
        const float* xsrc = (l == 0) ? inptr(F, I_X) : ((args.flags & 2) ? (const float*)args.out : nullptr);
        phase_prep(F, l, xsrc, l == 0 || (args.flags & 4), (args.flags & 1) ? (l == 0 ? 3 : 0) : (1 << l));
        SEAM();
    }
    if (IN(PH_KV)) if (l == 0 || !(args.flags & 1)) {
        SchedKV S{F.ws, (unsigned)WS_MEMB, (unsigned)WS_WKV_T, 2048u, 2048u, (args.flags & 1) ? 3 : (1 << l), F.G, (int)blockIdx.x};
        EpiKV E{(bf16_t*)(F.ws + WS_KV)};
        g8::gemm_phase(F.lds, S, E);
        SEAM();
    }
    if (IN(PH_P1)) {
        SchedGrid S{F.ws, (unsigned)WS_XB, (unsigned)WS_WIN_T, 2048u, 2048u, 64, 24, 16, F.G, (int)blockIdx.x};
        EpiInProj E{(const float*)(F.ws + WS_RSTD_MIX), (bf16_t*)(F.ws + WS_ABUF), (bf16_t*)(F.ws + WS_UBUF), (bf16_t*)(F.ws + WS_CXC), (bf16_t*)(F.ws + WS_CB), (bf16_t*)args.out, (bf16_t*)(F.ws + WS_G2)};
        g8::gemm_phase(F.lds, S, E);
        SEAM();
    }
    if (IN(PH_P2)) { phase_p2(F, l); SEAM(); }
    if (IN(PH_P3)) {
        SchedMerge S{F.ws, (unsigned)WS_AACT, (unsigned)WS_PIN, (unsigned)WS_CB, (unsigned)WS_WA_T, (unsigned)WS_WP_T, (unsigned)WS_WC_T, 1024u, 1024u, F.G, (int)blockIdx.x};
        EpiMerge E{(const bf16_t*)args.out, (const bf16_t*)(F.ws + WS_G2), (bf16_t*)(F.ws + WS_MERGED)};
        g8::gemm_phase(F.lds, S, E);
        SEAM();
    }
    if (IN(PH_P4)) {
        SchedGrid S{F.ws, (unsigned)WS_MERGED, (unsigned)WS_WO_T, 2048u, 2048u, 64, 4, 16, F.G, (int)blockIdx.x};
        EpiResid E{(bf16_t*)(F.ws + WS_XB), (float*)(F.ws + WS_PART)};
        g8::gemm_phase(F.lds, S, E);
        SEAM();
    }
    if (IN(PH_P5)) {
        SchedGrid S{F.ws, (unsigned)WS_XB, (unsigned)WS_WQ_T, 2048u, 2048u, 64, 4, 16, F.G, (int)blockIdx.x};
        EpiQ E{(const float*)(F.ws + WS_PART), (bf16_t*)(F.ws + WS_Q)};
        g8::gemm_phase(F.lds, S, E);
        SEAM();
    }
    if (IN(PH_P6)) { phase_attn(F, l); SEAM(); }
    if (IN(PH_P7)) {
        SchedGrid S{F.ws, (unsigned)WS_O, (unsigned)WS_WXO_T, 2048u, 2048u, 64, 4, 16, F.G, (int)blockIdx.x};
        EpiResid E{(bf16_t*)(F.ws + WS_XB), nullptr};
        g8::gemm_phase(F.lds, S, E);
        SEAM();
    }
    if (IN(PH_P8)) { phase_router(F, l); SEAM(); }
    if (IN(PH_P9)) {
        moe_table(F, l);
        SchedMoe1 S{F.ws, (unsigned)WS_XB, (unsigned)WS_WGU_T, (const int*)(F.ws + WS_ROWTOK), F.MISC, 2048u, 2048u, F.G, (int)blockIdx.x};
        EpiMoe1 E{(const float*)(F.ws + WS_ROWW), (const float*)(F.ws + WS_ROWRSTD), (bf16_t*)(F.ws + WS_ACT)};
        g8::gemm_phase_t<true>(F.lds, S, E);
        SEAM();
    }
    if (IN(PH_P10)) {
        moe_table(F, l);
        SchedMoe2 S{F.ws, (unsigned)WS_ACT, (unsigned)WS_WD_T, F.MISC, 512u, 512u, F.G, (int)blockIdx.x};
        EpiY E{(bf16_t*)(F.ws + WS_Y)};
        g8::gemm_phase(F.lds, S, E);
        SEAM();
    }
    if (IN(PH_P11)) {
        moe_table(F, l); phase_combine(F, args.out, l == 1);
        if (fused && l == 0) { phase_prep(F, 1, nullptr, false, 0); SEAM(); }
    }
    }
#ifdef PROBE_MASK
    STAMP();
    if (blockIdx.x == 0 && F.tid == 0) {
        unsigned long long tot = 0;
        for (int k = 0; k + 1 < n_stamp; ++k) if ((PROBE_MASK >> k) & 1u) { const unsigned long long a = ((unsigned long long)F.MISC[257 + 2 * k] << 32) | F.MISC[256 + 2 * k], b = ((unsigned long long)F.MISC[259 + 2 * k] << 32) | F.MISC[258 + 2 * k]; tot += b - a; }
        const unsigned long long t0 = __builtin_amdgcn_s_memrealtime();
        while (__builtin_amdgcn_s_memrealtime() - t0 < tot * PROBE_MULT) __builtin_amdgcn_s_sleep(16);
    }
#endif
#undef IN
#undef SEAM
}
}

static int g_grid = 0;
extern "C" void kernel_launch(void* const* d_in, const int* in_sizes, int n_in, void* d_out, int out_size, void* d_ws, size_t ws_size, hipStream_t stream) {
    if (g_grid == 0) {
        int dev = 0, cus = 0, per_cu = 0;
        if (n_in != 28 || ws_size < mk::WS_END || out_size != mk::NTOK * mk::DM) { fprintf(stderr, "kernel_launch: unexpected n_in %d / ws_size %zu / out_size %d\n", n_in, ws_size, out_size); g_grid = -1; return; }
        (void)hipGetDevice(&dev); (void)hipDeviceGetAttribute(&cus, hipDeviceAttributeMultiprocessorCount, dev);
        if (hipFuncSetAttribute((const void*)mk::mega, hipFuncAttributeMaxDynamicSharedMemorySize, mk::LDS_BYTES) != hipSuccess) { fprintf(stderr, "hipFuncSetAttribute failed\n"); g_grid = -1; return; }
        if (hipOccupancyMaxActiveBlocksPerMultiprocessor(&per_cu, (const void*)mk::mega, mk::NTHREADS, mk::LDS_BYTES) != hipSuccess || per_cu < 1) { fprintf(stderr, "occupancy query: %d workgroups per CU\n", per_cu); g_grid = -1; (void)hipGetLastError(); return; }
        g_grid = cus > 0 ? cus : 256;
    }
    if (g_grid < 0) return;
    (void)hipMemsetAsync((char*)d_ws + mk::WS_CTL, 0, mk::CTL_BYTES, stream);
    mk::Args a{};
    for (int i = 0; i < 28; ++i) a.in[i] = (const float*)d_in[i];
    a.out = (float*)d_out; a.ws = (unsigned char*)d_ws; a.ph_lo = 0; a.ph_hi = mk::PH_COUNT; a.layer = 0; a.flags = 1 | 8;
    hipLaunchKernelGGL(mk::mega, dim3(g_grid), dim3(mk::NTHREADS), mk::LDS_BYTES, stream, a);
}
```
